# Optimizing an MI355X kernel written in HIP

```python
import jax, jax.numpy as jnp
from jax import lax
import numpy as np

D_MODEL = 1024
BATCH = 8
SEQ = 8192
DEPTH = 2
DEC_BATCH = 4
DEC_SEQ = 4096
PAST_LEN = 128

MLA_HEADS = 4
MLA_NOPE = 128
MLA_ROPE = 64
MLA_VDIM = 128
MLA_Q_LORA = 256
MLA_KV_LORA = 128
MLA_WIDTH = MLA_HEADS * MLA_VDIM
MLA_SCALE = (MLA_NOPE + MLA_ROPE) ** -0.5
ROPE_BASE = 10000.0
Q_BLOCK = 128
POOL_WINDOWS = (2, 4, 8, 16)
POOL_GROUPS = len(POOL_WINDOWS)
POOL_WIDTH = D_MODEL // 4
POOL_GROUP_DIM = POOL_WIDTH // POOL_GROUPS
GLA_HEADS = 4
GLA_WIDTH = D_MODEL // 4
GLA_KEY = GLA_WIDTH // 2
GLA_DK = GLA_KEY // GLA_HEADS
GLA_DV = GLA_WIDTH // GLA_HEADS
GLA_GATE_RANK = 16
GLA_GATE_NORM = 16.0
GLA_CHUNK = 64

MIX_WIDTH = MLA_WIDTH + POOL_WIDTH + GLA_WIDTH
NORM_EPS = 1e-6

IN_SIZES = (MLA_Q_LORA, MLA_KV_LORA, MLA_ROPE, MLA_WIDTH,
            POOL_WIDTH, POOL_WIDTH,
            GLA_KEY, GLA_KEY, GLA_WIDTH, GLA_GATE_RANK, GLA_GATE_RANK, GLA_WIDTH)
IN_COLS = sum(IN_SIZES)
IN_SPLITS = tuple(int(v) for v in np.cumsum(IN_SIZES)[:-1])

kernel_name = "hymba_mla_pool_gla_encoder"


def rmsnorm(x, g):
    xf = x.astype(jnp.float32)
    y = xf * lax.rsqrt(jnp.mean(xf * xf, axis=-1, keepdims=True) + NORM_EPS)
    return (y * g.astype(jnp.float32)).astype(x.dtype)


def rope_tables(seq):
    inv_freq = 1.0 / (ROPE_BASE ** (jnp.arange(0, MLA_ROPE, 2, dtype=jnp.float32) / MLA_ROPE))
    ang = jnp.arange(seq, dtype=jnp.float32)[:, None] * inv_freq[None, :]
    return jnp.cos(ang), jnp.sin(ang)


def apply_rope(x, cos, sin):
    xf = x.astype(jnp.float32)
    x1, x2 = jnp.split(xf, 2, axis=-1)
    return jnp.concatenate([x1 * cos - x2 * sin, x2 * cos + x1 * sin], axis=-1).astype(x.dtype)


def mla_mixer(c_q, c_kv, k_rope, q_norm_g, w_uq, kv_norm_g, w_ukv):
    B, S, _ = c_q.shape
    q = jnp.einsum('bsr,re->bse', rmsnorm(c_q, q_norm_g), w_uq).reshape(B, S, MLA_HEADS, MLA_NOPE + MLA_ROPE)
    q_nope, q_rope = q[..., :MLA_NOPE], q[..., MLA_NOPE:]
    kv = jnp.einsum('bsr,re->bse', rmsnorm(c_kv, kv_norm_g), w_ukv).reshape(B, S, MLA_HEADS, MLA_NOPE + MLA_VDIM)
    k_nope, v = kv[..., :MLA_NOPE], kv[..., MLA_NOPE:]
    cos, sin = rope_tables(S)
    q_rope = apply_rope(q_rope, cos[None, :, None, :], sin[None, :, None, :])
    k_rope = apply_rope(k_rope, cos[None], sin[None])
    nb = S // Q_BLOCK
    qn_b = q_nope.reshape(B, nb, Q_BLOCK, MLA_HEADS, MLA_NOPE).transpose(1, 0, 2, 3, 4)
    qr_b = q_rope.reshape(B, nb, Q_BLOCK, MLA_HEADS, MLA_ROPE).transpose(1, 0, 2, 3, 4)

    def attend(blk):
        qn, qr = blk
        s = (jnp.einsum('bqhd,bkhd->bhqk', qn, k_nope, preferred_element_type=jnp.float32)
             + jnp.einsum('bqhr,bkr->bhqk', qr, k_rope, preferred_element_type=jnp.float32))
        p = jax.nn.softmax(s * MLA_SCALE, axis=-1)
        return jnp.einsum('bhqk,bkhd->bqhd', p.astype(v.dtype), v)

    o = lax.map(attend, (qn_b, qr_b))
    return o.transpose(1, 0, 2, 3, 4).reshape(B, S, MLA_WIDTH).astype(c_q.dtype)


def pool_mixer(u, w_pool, pool_scale):
    B, S, C = u.shape
    uf = u.astype(jnp.float32)
    cs = jnp.concatenate([jnp.zeros((B, 1, C), jnp.float32), jnp.cumsum(uf, axis=1)], axis=1)
    t = jnp.arange(S)
    outs = []
    for gi, w in enumerate(POOL_WINDOWS):
        lo = jnp.clip(t - w // 2, 0, S)
        hi = jnp.clip(t + w // 2, 0, S)
        csg = cs[..., gi * POOL_GROUP_DIM:(gi + 1) * POOL_GROUP_DIM]
        win_sum = jnp.take(csg, hi, axis=1) - jnp.take(csg, lo, axis=1)
        cnt = (hi - lo).astype(jnp.float32)[None, :, None]
        outs.append(win_sum / cnt)
    pooled = jnp.concatenate(outs, axis=-1) - uf
    pooled = pooled.reshape(B, S, POOL_GROUPS, POOL_GROUP_DIM).astype(u.dtype)
    y = jnp.einsum('bsgc,gcd->bsgd', pooled, w_pool).reshape(B, S, C)
    return (y * pool_scale).astype(u.dtype)


def gla_direction(q, k, v, g):
    B, S, H, DK = q.shape
    DV = v.shape[-1]
    n = S // GLA_CHUNK

    def to_chunks(a):
        return a.reshape(B, n, GLA_CHUNK, H, a.shape[-1]).transpose(1, 0, 3, 2, 4)

    mask = jnp.tril(jnp.ones((GLA_CHUNK, GLA_CHUNK), dtype=bool))[None, None, :, :, None]

    def step(state, inp):
        qc, kc, vc, gc = inp
        b = jnp.cumsum(gc, axis=2)
        o_inter = jnp.einsum('bhcd,bhde->bhce', qc * jnp.exp(b), state)
        decay = jnp.exp(jnp.where(mask, b[:, :, :, None, :] - b[:, :, None, :, :], -jnp.inf))
        a = jnp.einsum('bhid,bhijd,bhjd->bhij', qc, decay, kc)
        o = o_inter + jnp.einsum('bhij,bhje->bhie', a, vc)
        b_last = b[:, :, -1, :]
        state = (jnp.exp(b_last)[..., None] * state
                 + jnp.einsum('bhcd,bhce->bhde', kc * jnp.exp(b_last[:, :, None, :] - b), vc))
        return state, o

    s0 = jnp.zeros((B, H, DK, DV), jnp.float32)
    _, o = lax.scan(step, s0, (to_chunks(q), to_chunks(k), to_chunks(v), to_chunks(g)))
    return o.transpose(1, 0, 3, 2, 4).reshape(B, S, H, DV)


def gla_mixer(q_in, k_in, v_in, lr_fwd, lr_bwd, gk_up_fwd, gk_bias_fwd, gk_up_bwd, gk_bias_bwd, gla_norm_g):
    B, S, _ = q_in.shape
    f32 = jnp.float32
    q = q_in.astype(f32).reshape(B, S, GLA_HEADS, GLA_DK) * (GLA_DK ** -0.5)
    k = k_in.astype(f32).reshape(B, S, GLA_HEADS, GLA_DK)
    v = v_in.astype(f32).reshape(B, S, GLA_HEADS, GLA_DV)

    def log_gate(lr, up, bias):
        z = jnp.einsum('bsr,rk->bsk', lr, up).astype(f32) + bias.astype(f32)
        return (jax.nn.log_sigmoid(z) / GLA_GATE_NORM).reshape(B, S, GLA_HEADS, GLA_DK)

    g_f = log_gate(lr_fwd, gk_up_fwd, gk_bias_fwd)
    g_b = log_gate(lr_bwd, gk_up_bwd, gk_bias_bwd)
    o_f = gla_direction(q, k, v, g_f)
    o_b = gla_direction(q[:, ::-1], k[:, ::-1], v[:, ::-1], g_b[:, ::-1])[:, ::-1]
    o = rmsnorm(o_f + o_b, gla_norm_g)
    return o.reshape(B, S, GLA_WIDTH).astype(q_in.dtype)


def hybrid_layer(x, norm_g, w_in, q_norm_g, w_uq, kv_norm_g, w_ukv, w_pool, pool_scale,
                 gk_up_fwd, gk_bias_fwd, gk_up_bwd, gk_bias_bwd, gla_norm_g, w_out):
    h = rmsnorm(x, norm_g)
    z = jnp.einsum('bsd,de->bse', h, w_in)
    (c_q, c_kv, k_rope, gate_mla, u_pool, gate_pool,
     q_gla, k_gla, v_gla, lr_fwd, lr_bwd, gate_gla) = jnp.split(z, IN_SPLITS, axis=-1)
    o_mla = mla_mixer(c_q, c_kv, k_rope, q_norm_g, w_uq, kv_norm_g, w_ukv)
    o_pool = pool_mixer(u_pool, w_pool, pool_scale)
    o_gla = gla_mixer(q_gla, k_gla, v_gla, lr_fwd, lr_bwd, gk_up_fwd, gk_bias_fwd,
                      gk_up_bwd, gk_bias_bwd, gla_norm_g)
    mixed = jnp.concatenate([o_mla * jax.nn.silu(gate_mla),
                             o_pool * jax.nn.silu(gate_pool),
                             o_gla * jax.nn.silu(gate_gla)], axis=-1).astype(x.dtype)
    return x + jnp.einsum('bse,ed->bsd', mixed, w_out)


def setup_inputs(seed: int = 0) -> dict:
    key = jax.random.key(seed)
    ks = jax.random.split(key, 20)
    f32 = jnp.float32

    def nrm(k, shape, fan_in):
        return jax.random.normal(k, shape, f32) * (fan_in ** -0.5)

    def gain(k, shape):
        return 1.0 + 0.02 * jax.random.normal(k, shape, f32)

    return {
        "x_prompt": jax.random.normal(ks[0], (BATCH, SEQ, D_MODEL), f32),
        "x_sample": jax.random.normal(ks[1], (DEC_BATCH, DEC_SEQ, D_MODEL), f32),
        "norm_g": gain(ks[2], (DEPTH, D_MODEL)),
        "w_in": nrm(ks[3], (DEPTH, D_MODEL, IN_COLS), D_MODEL),
        "q_norm_g": gain(ks[4], (DEPTH, MLA_Q_LORA)),
        "w_uq": nrm(ks[5], (DEPTH, MLA_Q_LORA, MLA_HEADS * (MLA_NOPE + MLA_ROPE)), MLA_Q_LORA),
        "kv_norm_g": gain(ks[6], (DEPTH, MLA_KV_LORA)),
        "w_ukv": nrm(ks[7], (DEPTH, MLA_KV_LORA, MLA_HEADS * (MLA_NOPE + MLA_VDIM)), MLA_KV_LORA),
        "w_pool": nrm(ks[8], (DEPTH, POOL_GROUPS, POOL_GROUP_DIM, POOL_GROUP_DIM), POOL_GROUP_DIM),
        "pool_scale": gain(ks[9], (DEPTH, POOL_WIDTH)),
        "gk_up_fwd": nrm(ks[10], (DEPTH, GLA_GATE_RANK, GLA_KEY), GLA_GATE_RANK),
        "gk_bias_fwd": 0.1 * jax.random.normal(ks[11], (DEPTH, GLA_KEY), f32),
        "gk_up_bwd": nrm(ks[12], (DEPTH, GLA_GATE_RANK, GLA_KEY), GLA_GATE_RANK),
        "gk_bias_bwd": 0.1 * jax.random.normal(ks[13], (DEPTH, GLA_KEY), f32),
        "gla_norm_g": gain(ks[14], (DEPTH, GLA_DV)),
        "w_out": nrm(ks[15], (DEPTH, MIX_WIDTH, D_MODEL), MIX_WIDTH),
        "final_norm_g": gain(ks[16], (D_MODEL,)),
    }


def reference(x_prompt, x_sample, norm_g, w_in, q_norm_g, w_uq, kv_norm_g, w_ukv, w_pool, pool_scale,
              gk_up_fwd, gk_bias_fwd, gk_up_bwd, gk_bias_bwd, gla_norm_g, w_out, final_norm_g):
    def trunk(x):
        for l in range(DEPTH):
            x = hybrid_layer(x, norm_g[l], w_in[l], q_norm_g[l], w_uq[l], kv_norm_g[l], w_ukv[l],
                             w_pool[l], pool_scale[l], gk_up_fwd[l], gk_bias_fwd[l], gk_up_bwd[l],
                             gk_bias_bwd[l], gla_norm_g[l], w_out[l])
        return rmsnorm(x, final_norm_g)

    y_prompt = trunk(x_prompt)
    y_sample = trunk(x_sample)
    return (y_prompt, y_sample)
```

```cpp
#include <hip/hip_runtime.h>
#include <hip/hip_cooperative_groups.h>
#include <cstdio>
#include <cstdint>
namespace cg = cooperative_groups;

typedef unsigned short u16;
using bf16x8 = __attribute__((ext_vector_type(8))) short;
using s16x4  = __attribute__((ext_vector_type(4))) short;
using f32x16 = __attribute__((ext_vector_type(16))) float;
using f32x8  = __attribute__((ext_vector_type(8))) float;
using f32x4  = __attribute__((ext_vector_type(4))) float;
using u32x4  = __attribute__((ext_vector_type(4))) unsigned;
#define DI __device__ __forceinline__
#define SBAR() __builtin_amdgcn_sched_barrier(0)

constexpr int NTOK = 81920, NP = 65536;
constexpr int DM = 1024, ZLD = 2304, INC = 2272;
constexpr int ZQ = 0, ZKV = 256, ZKR = 384, ZGM = 448, ZUP = 960, ZGP = 1216, ZGQ = 1472, ZGK = 1600, ZGV = 1728, ZLF = 1984, ZLB = 2000, ZGG = 2016;
constexpr int NCHUNK = NTOK / 64;
constexpr float EPS = 1e-6f;
constexpr float MLA_SCALE = 0.07216878364870322f;

constexpr size_t SZ_WIN = (size_t)ZLD * 1024 * 2, SZ_WOUT = (size_t)1024 * 1024 * 2, SZ_WQ = (size_t)768 * 256 * 2, SZ_WUV = (size_t)512 * 128 * 2;
constexpr size_t OFF_WIN = 0;
constexpr size_t OFF_WOUT = OFF_WIN + 2 * SZ_WIN;
constexpr size_t OFF_WQ = OFF_WOUT + 2 * SZ_WOUT;
constexpr size_t OFF_WUV = OFF_WQ + 2 * SZ_WQ;
constexpr size_t OFF_CS = OFF_WUV + 2 * SZ_WUV;
constexpr size_t OFF_Z = OFF_CS + (size_t)8192 * 32 * 8;
constexpr size_t OFF_Q = OFF_Z + (size_t)NTOK * ZLD * 2;
constexpr size_t OFF_K = OFF_Q + (size_t)NTOK * 768 * 2;
constexpr size_t OFF_OL = OFF_K + (size_t)NTOK * 192 * 2;
constexpr size_t OFF_MIX = OFF_OL + (size_t)NTOK * 512 * 2;
constexpr size_t OFF_GC = OFF_MIX + (size_t)NTOK * 1024 * 2;
constexpr size_t OFF_LST = OFF_GC + (size_t)NTOK * 256 * 4;
constexpr size_t OFF_DK = OFF_LST + (size_t)2 * NCHUNK * 4 * 2048 * 4;
constexpr size_t OFF_VT = OFF_DK + (size_t)2 * NCHUNK * 4 * 32 * 4;
constexpr size_t OFF_RS0 = OFF_VT + (size_t)NCHUNK * 256 * 64 * 2;
constexpr size_t OFF_RS1 = OFF_RS0 + (size_t)NTOK * 4;
constexpr size_t OFF_RS2 = OFF_RS1 + (size_t)NTOK * 4;
constexpr size_t OFF_SC = OFF_RS2 + (size_t)NTOK * 4;
constexpr size_t WS_END = OFF_SC + 512;

struct Params {
  const float* x_prompt; const float* x_sample; const float* norm_g; const float* w_in; const float* q_norm_g; const float* w_uq;
  const float* kv_norm_g; const float* w_ukv; const float* w_pool; const float* pool_scale; const float* gk_up_fwd; const float* gk_bias_fwd;
  const float* gk_up_bwd; const float* gk_bias_bwd; const float* gla_norm_g; const float* w_out; const float* final_norm_g;
  float* out; char* ws;
};

DI int otid() { int t = threadIdx.x; asm volatile("" : "+v"(t)); return t; }
DI int crow(int r, int hi) { return (r & 3) + 8 * (r >> 2) + 4 * hi; }
typedef __bf16 bf16v2 __attribute__((ext_vector_type(2)));
typedef float f32v2 __attribute__((ext_vector_type(2)));
DI unsigned cvtpk(float lo, float hi) { f32v2 f = {lo, hi}; return __builtin_bit_cast(unsigned, __builtin_convertvector(f, bf16v2)); }
DI unsigned cvtpkv(float lo, float hi) { unsigned r; asm volatile("v_cvt_pk_bf16_f32 %0, %1, %2" : "=v"(r) : "v"(lo), "v"(hi)); return r; }
DI float bf2f(u16 v) { return __uint_as_float(((unsigned)v) << 16); }
DI u16 f2bf(float x) { return (u16)(cvtpk(x, 0.f) & 0xffffu); }
DI bf16x8 cvt8(f32x8 x) { u32x4 w = {cvtpk(x[0], x[1]), cvtpk(x[2], x[3]), cvtpk(x[4], x[5]), cvtpk(x[6], x[7])}; return __builtin_bit_cast(bf16x8, w); }
DI float silu(float x) { return x / (1.f + __expf(-x)); }
DI float logsig(float x) { return fminf(x, 0.f) - log1pf(__expf(-fabsf(x))); }
#define MFMA32(a, b, c) __builtin_amdgcn_mfma_f32_32x32x16_bf16((a), (b), (c), 0, 0, 0)
DI bf16x8 pack8(const f32x16& x, int s) {
  u32x4 w = {cvtpk(x[8 * s + 0], x[8 * s + 1]), cvtpk(x[8 * s + 2], x[8 * s + 3]), cvtpk(x[8 * s + 4], x[8 * s + 5]), cvtpk(x[8 * s + 6], x[8 * s + 7])};
  return __builtin_bit_cast(bf16x8, w);
}
DI int tok_pos(int g) { return g < NP ? (g & 8191) : ((g - NP) & 4095); }

constexpr int G_ASZ = 256 * 128, G_BSZ = 128 * 128, G_STAGE = G_ASZ + G_BSZ;
constexpr int SHM_GEMM = 2 * (G_ASZ + 256 * 128) + 1024;
DI int gswz(int row, int chunk) { return row * 128 + ((chunk ^ ((row >> 1) & 7)) << 4); }
enum { EPI_Z = 0, EPI_Q = 1, EPI_GATE = 2, EPI_RES = 3 };
struct Epi {
  u16* outb; long ldo;
  float* outf; const float* resid;
  const u16* gate;
  const float2* cs;
  u16* vt;
};

template <int EPI, int MT>
DI void gemm_tile(const u16* __restrict__ Av, long lda, const u16* __restrict__ Bt, long ldb, int K, long m0, int n0, char* lds, const Epi& ep) {
  constexpr bool RS = (EPI == EPI_Z || EPI == EPI_Q);
  constexpr int BN = MT == 2 ? 128 : 256, NB = BN / 64, BSZ = BN * 128, STAGE = G_ASZ + BSZ;
  const int tid = otid(), wid = tid >> 6, lane = tid & 63, r32 = lane & 31, hi = lane >> 5;
  const int wm = MT == 2 ? (wid >> 1) : (wid >> 2), wn = MT == 2 ? (wid & 1) : (wid & 3);
  const int srow = tid >> 3, sch = tid & 7;
  float* rs_l = (float*)(lds + 2 * STAGE);
  f32x16 acc[MT][2];
#pragma unroll
  for (int a = 0; a < MT; ++a)
#pragma unroll
    for (int b = 0; b < 2; ++b)
#pragma unroll
      for (int r = 0; r < 16; ++r) acc[a][b][r] = 0.f;
  float ss0 = 0.f, ss1 = 0.f, ss2 = 0.f, ss3 = 0.f;
  const int KT = K >> 6;
  bf16x8 a0_0, a0_1, a0_2, a0_3, b0_0, b0_1, b0_2, b0_3;
  bf16x8 a1_0, a1_1, a1_2, a1_3, b1_0, b1_1, b1_2, b1_3;
  const u16* Ab = Av + (m0 + srow) * lda + sch * 8;
  const u16* Bp = Bt + (long)(n0 + srow) * ldb + sch * 8;
  const int so0 = gswz(srow, sch), so1 = gswz(srow + 64, sch), so2 = gswz(srow + 128, sch), so3 = gswz(srow + 192, sch);
#define GLOAD(S, kt) do { a##S##_0 = *(const bf16x8*)(Ab + (kt) * 64); a##S##_1 = *(const bf16x8*)(Ab + 64 * lda + (kt) * 64);                         \
    a##S##_2 = *(const bf16x8*)(Ab + 128 * lda + (kt) * 64); a##S##_3 = *(const bf16x8*)(Ab + 192 * lda + (kt) * 64);                                    \
    b##S##_0 = *(const bf16x8*)(Bp + (kt) * 64); b##S##_1 = *(const bf16x8*)(Bp + 64 * ldb + (kt) * 64);                                                 \
    if constexpr (NB == 4) { b##S##_2 = *(const bf16x8*)(Bp + 128 * ldb + (kt) * 64); b##S##_3 = *(const bf16x8*)(Bp + 192 * ldb + (kt) * 64); } } while (0)
#define SSQB(v, s) do { _Pragma("unroll") for (int j_ = 0; j_ < 8; ++j_) { float f_ = bf2f((u16)v[j_]); s = fmaf(f_, f_, s); } } while (0)
#define GSTORE(S, buf, real) do { char* base_ = lds + (buf) * STAGE;                                                                                      \
    if constexpr (RS) if (real) { SSQB(a##S##_0, ss0); SSQB(a##S##_1, ss1); SSQB(a##S##_2, ss2); SSQB(a##S##_3, ss3); }                                  \
    *(bf16x8*)(base_ + so0) = a##S##_0; *(bf16x8*)(base_ + so1) = a##S##_1; *(bf16x8*)(base_ + so2) = a##S##_2; *(bf16x8*)(base_ + so3) = a##S##_3;      \
    *(bf16x8*)(base_ + G_ASZ + so0) = b##S##_0; *(bf16x8*)(base_ + G_ASZ + so1) = b##S##_1;                                                              \
    if constexpr (NB == 4) { *(bf16x8*)(base_ + G_ASZ + so2) = b##S##_2; *(bf16x8*)(base_ + G_ASZ + so3) = b##S##_3; } } while (0)
#define GCOMP(buf) do { const char* Ab_l = lds + (buf) * STAGE; const char* Bb_l = Ab_l + G_ASZ;                                                          \
    _Pragma("unroll") for (int s = 0; s < 4; ++s) { const int ch = s * 2 + hi;                                                                           \
      bf16x8 fa[MT], fb0, fb1;                                                                                                                            \
      _Pragma("unroll") for (int mt = 0; mt < MT; ++mt) fa[mt] = *(const bf16x8*)(Ab_l + gswz(wm * (MT * 32) + mt * 32 + r32, ch));                       \
      fb0 = *(const bf16x8*)(Bb_l + gswz(wn * 64 + r32, ch)); fb1 = *(const bf16x8*)(Bb_l + gswz(wn * 64 + 32 + r32, ch));                               \
      _Pragma("unroll") for (int mt = 0; mt < MT; ++mt) {                                                                                                 \
        acc[mt][0] = __builtin_amdgcn_mfma_f32_32x32x16_bf16(fb0, fa[mt], acc[mt][0], 0, 0, 0);                    \
        acc[mt][1] = __builtin_amdgcn_mfma_f32_32x32x16_bf16(fb1, fa[mt], acc[mt][1], 0, 0, 0); }                                                          \
      if constexpr (MT == 4) SBAR(); } } while (0)
  asm volatile("s_waitcnt vmcnt(0)" ::: "memory");
  __syncthreads();
  if constexpr (MT == 2) {
    GLOAD(0, 0); SBAR(); GLOAD(1, 1); SBAR();
    GSTORE(0, 0, true); SBAR(); GLOAD(0, min(2, KT - 1)); SBAR();
    __syncthreads();
#pragma unroll 1
    for (int kt = 0; kt < KT; kt += 2) {
      GCOMP(0);
      GSTORE(1, 1, true);
      GLOAD(1, min(kt + 3, KT - 1));
      __syncthreads();
      GCOMP(1);
      GSTORE(0, 0, kt + 2 < KT);
      GLOAD(0, min(kt + 4, KT - 1));
      __syncthreads();
    }
  } else {
    GLOAD(0, 0); GSTORE(0, 0, true);
    __syncthreads();
#pragma unroll 1
    for (int kt = 0; kt < KT; kt += 2) {
      GLOAD(0, kt + 1); SBAR();
      GCOMP(0);
      GSTORE(0, 1, true);
      __syncthreads();
      GLOAD(0, min(kt + 2, KT - 1)); SBAR();
      GCOMP(1);
      GSTORE(0, 0, kt + 2 < KT);
      __syncthreads();
    }
  }
#undef GLOAD
#undef GSTORE
#undef GCOMP
#undef SSQB
  if constexpr (RS) {
    float s4[4] = {ss0, ss1, ss2, ss3};
#pragma unroll
    for (int i = 0; i < 4; ++i) {
      float s = s4[i];
      s += __shfl_xor(s, 1); s += __shfl_xor(s, 2); s += __shfl_xor(s, 4);
      if (sch == 0) rs_l[srow + 64 * i] = rsqrtf(s / (float)K + EPS);
    }
    __syncthreads();
  }
  const bool rope = (EPI == EPI_Q) && (((n0 + wn * 64) % 192) == 128);
  const bool isV = (EPI == EPI_Z) && (n0 + wn * 64 >= ZGV) && (n0 + wn * 64 < ZGV + 256);
#pragma unroll
  for (int mt = 0; mt < MT; ++mt) {
    const int rl = wm * (MT * 32) + mt * 32 + r32;
    const long g = m0 + rl;
    float rs = 1.f;
    if constexpr (RS) rs = rs_l[rl];
#pragma unroll
    for (int q = 0; q < 4; ++q) {
      const int cq = n0 + wn * 64 + 8 * q + 4 * hi;
      float v0[4], v1[4];
#pragma unroll
      for (int j = 0; j < 4; ++j) { v0[j] = acc[mt][0][4 * q + j] * rs; v1[j] = acc[mt][1][4 * q + j] * rs; }
      if constexpr (EPI == EPI_Z) {
        uint2 w0, w1; w0.x = cvtpk(v0[0], v0[1]); w0.y = cvtpk(v0[2], v0[3]); w1.x = cvtpk(v1[0], v1[1]); w1.y = cvtpk(v1[2], v1[3]);
        *(uint2*)(ep.outb + g * ep.ldo + cq) = w0; *(uint2*)(ep.outb + g * ep.ldo + cq + 32) = w1;
        if (isV) {
          u16* vp = ep.vt + ((g >> 6) * 256 + (cq - ZGV)) * 64 + (g & 63);
          vp[0 * 64] = (u16)(w0.x & 0xffff); vp[1 * 64] = (u16)(w0.x >> 16); vp[2 * 64] = (u16)(w0.y & 0xffff); vp[3 * 64] = (u16)(w0.y >> 16);
          vp[32 * 64] = (u16)(w1.x & 0xffff); vp[33 * 64] = (u16)(w1.x >> 16); vp[34 * 64] = (u16)(w1.y & 0xffff); vp[35 * 64] = (u16)(w1.y >> 16);
        }
      } else if constexpr (EPI == EPI_Q) {
        if (rope) {
          const f32x8 cs = *(const f32x8*)((const float*)ep.cs + ((long)tok_pos((int)g) * 32 + 8 * q + 4 * hi) * 2);
#pragma unroll
          for (int j = 0; j < 4; ++j) { const float x1 = v0[j], x2 = v1[j]; v0[j] = x1 * cs[2 * j] - x2 * cs[2 * j + 1]; v1[j] = x2 * cs[2 * j] + x1 * cs[2 * j + 1]; }
        }
        uint2 w0, w1; w0.x = cvtpk(v0[0], v0[1]); w0.y = cvtpk(v0[2], v0[3]); w1.x = cvtpk(v1[0], v1[1]); w1.y = cvtpk(v1[2], v1[3]);
        *(uint2*)(ep.outb + g * ep.ldo + cq) = w0; *(uint2*)(ep.outb + g * ep.ldo + cq + 32) = w1;
      } else if constexpr (EPI == EPI_GATE) {
        const uint2 g0 = *(const uint2*)(ep.gate + g * ZLD + cq), g1 = *(const uint2*)(ep.gate + g * ZLD + cq + 32);
        v0[0] *= silu(__uint_as_float(g0.x << 16)); v0[1] *= silu(__uint_as_float(g0.x & 0xffff0000u)); v0[2] *= silu(__uint_as_float(g0.y << 16)); v0[3] *= silu(__uint_as_float(g0.y & 0xffff0000u));
        v1[0] *= silu(__uint_as_float(g1.x << 16)); v1[1] *= silu(__uint_as_float(g1.x & 0xffff0000u)); v1[2] *= silu(__uint_as_float(g1.y << 16)); v1[3] *= silu(__uint_as_float(g1.y & 0xffff0000u));
        uint2 w0, w1; w0.x = cvtpk(v0[0], v0[1]); w0.y = cvtpk(v0[2], v0[3]); w1.x = cvtpk(v1[0], v1[1]); w1.y = cvtpk(v1[2], v1[3]);
        *(uint2*)(ep.outb + g * ep.ldo + cq) = w0; *(uint2*)(ep.outb + g * ep.ldo + cq + 32) = w1;
      } else {
        const f32x4 r0 = *(const f32x4*)(ep.resid + g * 1024 + cq), r1 = *(const f32x4*)(ep.resid + g * 1024 + cq + 32);
#pragma unroll
        for (int j = 0; j < 4; ++j) { v0[j] += r0[j]; v1[j] += r1[j]; }
        *(f32x4*)(ep.outf + g * 1024 + cq) = f32x4{v0[0], v0[1], v0[2], v0[3]}; *(f32x4*)(ep.outf + g * 1024 + cq + 32) = f32x4{v1[0], v1[1], v1[2], v1[3]};
        if (ep.outb) { uint2 w0, w1; w0.x = cvtpk(v0[0], v0[1]); w0.y = cvtpk(v0[2], v0[3]); w1.x = cvtpk(v1[0], v1[1]); w1.y = cvtpk(v1[2], v1[3]);
          *(uint2*)(ep.outb + g * 1024 + cq) = w0; *(uint2*)(ep.outb + g * 1024 + cq + 32) = w1; }
      }
    }
    SBAR();
  }
}

namespace pg8 {
#define PG8_LAS __attribute__((address_space(3)))
typedef unsigned short bf16_t;
constexpr int BM = 256, BK = 64, HALF = 128, HTB = HALF * BK * 2, STAGE_BYTES = 8 * HTB, NXCD = 8, WGM = 8;
DI int lds_byte(int r, int c) { const int st = (r >> 4) * 2 + (c >> 5), rr = r & 15, cc = c & 31, ob = rr * 64 + cc * 2; return st * 1024 + (ob ^ (((ob >> 9) & 1) << 5)); }
DI void stage_rc(int b, int& R, int& C) { const int st = b / 1024, sb = b % 1024, swz = sb ^ (((sb >> 9) & 1) << 5); R = (st >> 1) * 16 + swz / 64; C = (st & 1) * 32 + (swz % 64) / 2; }
DI int perm32(int rho) { const int n = rho >> 4, i = rho & 15; return 8 * (i >> 2) + 4 * n + (i & 3); }
struct Unit { int pm, pn; };
struct Gemm { const bf16_t* A; const bf16_t* Bt; int M, N, K; };
struct StaticOrder {
    int nM, nN, nwg, G, c;
    DI void init(int M, int N, int G_, int c_) { nM = M / BM; nN = N / BM; nwg = nM * nN; G = G_; c = c_; }
    DI bool next(int i, Unit& u) const {
        const long L = (long)i * G + c; if (L >= nwg) return false;
        int wgid = (int)L; { const int q = nwg / NXCD, r = nwg % NXCD, xcd = wgid % NXCD, off = wgid / NXCD; wgid = (xcd < r ? xcd * (q + 1) : r * (q + 1) + (xcd - r) * q) + off; }
        const int nig = WGM * nN, gid = wgid / nig, fm = gid * WGM, gsz = (nM - fm) < WGM ? (nM - fm) : WGM;
        u.pm = fm + ((wgid % nig) % gsz); u.pn = (wgid % nig) / gsz; return true;
    }
    DI void a_ready(const Unit&) const {}
    DI void done(const Unit&) const {}
};
template <class Epi, class Sched>
__device__ __forceinline__ void gemm_phase(PG8_LAS unsigned char* lds, const Gemm g, const Sched& S, const Epi& E) {
    const int tid = otid(), wid = __builtin_amdgcn_readfirstlane(tid >> 6), lane = tid & 63, wr = wid >> 2, wc = wid & 3, fr = lane & 15, fq = lane >> 4;
    const int K = g.K, nt = K / BK;
    unsigned voffA[2], voffB[2];
#pragma unroll
    for (int i = 0; i < 2; ++i) { int R, C; stage_rc(tid * 16 + i * 8192, R, C); const int Rb = Epi::PERM ? ((R & ~31) + perm32(R & 31)) : R;
        voffA[i] = (unsigned)(R * K + C) * 2u; voffB[i] = (unsigned)(Rb * K + C) * 2u; }
    const size_t kstep = (size_t)(BK * 2);
    const size_t hstep = (size_t)HALF * K * 2;
    const size_t tstep = 2 * hstep;
    const unsigned ldsw = (unsigned)wid * 1024u;
    const int aoff = lds_byte(wr * 64 + fr, fq * 8), boff = lds_byte(wc * 32 + fr, fq * 8);
#define PG8_SA(b, h) (((b) * 2 + (h)) * HTB)
#define PG8_SB(b, h) ((4 + (b) * 2 + (h)) * HTB)
#define PG8_STAGE(bufoff, gbase, voff) do { _Pragma("unroll") for (int _i = 0; _i < 2; ++_i) \
        __builtin_amdgcn_global_load_lds((const unsigned*)((const char*)(gbase) + (voff)[_i]), (PG8_LAS unsigned*)(lds + (bufoff) + ldsw + _i * 8192), 16, 0, 0); } while (0)
#define PG8_LDA(dst, b, h) do { _Pragma("unroll") for (int m = 0; m < 4; ++m) _Pragma("unroll") for (int k = 0; k < 2; ++k) dst[m][k] = *(const PG8_LAS bf16x8*)(lds + PG8_SA(b, h) + aoff + m * 2048 + k * 1024); } while (0)
#define PG8_LDB(dst, b, h) do { _Pragma("unroll") for (int n = 0; n < 2; ++n) _Pragma("unroll") for (int k = 0; k < 2; ++k) dst[n][k] = *(const PG8_LAS bf16x8*)(lds + PG8_SB(b, h) + boff + n * 2048 + k * 1024); } while (0)
#define PG8_MMA(ai, bj, At, Bt) do { __builtin_amdgcn_s_setprio(1); _Pragma("unroll") for (int m = 0; m < 4; ++m) _Pragma("unroll") for (int n = 0; n < 2; ++n) _Pragma("unroll") for (int k = 0; k < 2; ++k) \
        acc[ai][bj][m][n] = __builtin_amdgcn_mfma_f32_16x16x32_bf16(Bt[n][k], At[m][k], acc[ai][bj][m][n], 0, 0, 0); __builtin_amdgcn_s_setprio(0); } while (0)
#define PG8_WAIT_V(n) asm volatile("s_waitcnt vmcnt(" #n ")" ::: "memory")
#define PG8_WAIT_L(n) asm volatile("s_waitcnt lgkmcnt(" #n ")" ::: "memory")
#define PG8_BAR __builtin_amdgcn_s_barrier()
#define PG8_SCHED __builtin_amdgcn_sched_barrier(0)
    Unit cur, nxt; int ui = 0;
    if (!S.next(0, cur)) return;
    f32x4 acc[2][2][4][2];
#pragma unroll
    for (int a = 0; a < 2; ++a)
#pragma unroll
        for (int b = 0; b < 2; ++b)
#pragma unroll
            for (int m = 0; m < 4; ++m)
#pragma unroll
                for (int n = 0; n < 2; ++n) acc[a][b][m][n] = (f32x4){0.f, 0.f, 0.f, 0.f};
    bf16x8 At[4][2], B0[2][2], B1[2][2];
    const char* cA = (const char*)g.A + (size_t)cur.pm * tstep; const char* cB = (const char*)g.Bt + (size_t)cur.pn * tstep;
    S.a_ready(cur);
    PG8_STAGE(PG8_SB(0, 0), cB, voffB); PG8_STAGE(PG8_SA(0, 0), cA, voffA); PG8_STAGE(PG8_SB(0, 1), cB + hstep, voffB); PG8_STAGE(PG8_SA(0, 1), cA + hstep, voffA);
    if (wr == 1) PG8_BAR;
    PG8_WAIT_V(4); PG8_BAR;
    PG8_STAGE(PG8_SB(1, 0), cB + kstep, voffB); PG8_STAGE(PG8_SA(1, 0), cA + kstep, voffA); PG8_STAGE(PG8_SB(1, 1), cB + hstep + kstep, voffB);
    PG8_WAIT_V(6); PG8_BAR;
    for (;;) {
        const bool has_next = S.next(ui + 1, nxt);
        const char* nA = has_next ? (const char*)g.A + (size_t)nxt.pm * tstep : cA; const char* nB = has_next ? (const char*)g.Bt + (size_t)nxt.pn * tstep : cB;
        for (int t = 0; t < nt; t += 2) {
            const bool last = (t == nt - 2);
            const char* a1 = cA + (size_t)(t + 1) * kstep;
            const char* a2 = last ? nA : cA + (size_t)(t + 2) * kstep; const char* b2 = last ? nB : cB + (size_t)(t + 2) * kstep;
            const char* a3 = a2 + kstep; const char* b3 = b2 + kstep;
            if (last && has_next) S.a_ready(nxt);
            PG8_LDB(B0, 0, 0); PG8_SCHED; PG8_LDA(At, 0, 0); PG8_STAGE(PG8_SA(1, 1), a1 + hstep, voffA);
            PG8_WAIT_L(8); PG8_BAR; PG8_WAIT_L(0); PG8_MMA(0, 0, At, B0); PG8_BAR; PG8_SCHED;
            PG8_LDB(B1, 0, 1); PG8_STAGE(PG8_SB(0, 0), b2, voffB);
            PG8_BAR; PG8_WAIT_L(0); PG8_MMA(0, 1, At, B1); PG8_BAR;
            PG8_LDA(At, 0, 1); PG8_STAGE(PG8_SA(0, 0), a2, voffA);
            PG8_BAR; PG8_WAIT_L(0); PG8_MMA(1, 0, At, B0); PG8_BAR; PG8_SCHED;
            PG8_STAGE(PG8_SB(0, 1), b2 + hstep, voffB);
            PG8_WAIT_V(6); PG8_BAR; PG8_MMA(1, 1, At, B1); PG8_BAR;
            PG8_LDB(B0, 1, 0); PG8_SCHED; PG8_LDA(At, 1, 0); PG8_STAGE(PG8_SA(0, 1), a2 + hstep, voffA);
            PG8_WAIT_L(8); PG8_BAR; PG8_WAIT_L(0); PG8_MMA(0, 0, At, B0); PG8_BAR; PG8_SCHED;
            PG8_LDB(B1, 1, 1); PG8_STAGE(PG8_SB(1, 0), b3, voffB);
            PG8_BAR; PG8_WAIT_L(0); PG8_MMA(0, 1, At, B1); PG8_BAR;
            PG8_LDA(At, 1, 1); PG8_STAGE(PG8_SA(1, 0), a3, voffA);
            PG8_BAR; PG8_WAIT_L(0); PG8_MMA(1, 0, At, B0); PG8_BAR; PG8_SCHED;
            PG8_STAGE(PG8_SB(1, 1), b3 + hstep, voffB);
            PG8_WAIT_V(6); PG8_BAR; PG8_MMA(1, 1, At, B1); PG8_BAR;
        }
        if constexpr (!Epi::AFTER_DRAIN) { E(acc, cur, wr, wc, fr, fq); S.done(cur); }
        if (!has_next) break;
#pragma unroll
        for (int a = 0; a < 2; ++a)
#pragma unroll
            for (int b = 0; b < 2; ++b)
#pragma unroll
                for (int m = 0; m < 4; ++m)
#pragma unroll
                    for (int n = 0; n < 2; ++n) acc[a][b][m][n] = (f32x4){0.f, 0.f, 0.f, 0.f};
        cur = nxt; cA = nA; cB = nB; ++ui;
    }
    PG8_WAIT_V(0);
    if (wr == 0) PG8_BAR;
    PG8_BAR;
    if constexpr (Epi::AFTER_DRAIN) { E.fused(acc, cur, wr, wc, fr, fq, lds, wid, lane); S.done(cur); }
#undef PG8_SA
#undef PG8_SB
#undef PG8_STAGE
#undef PG8_LDA
#undef PG8_LDB
#undef PG8_MMA
#undef PG8_WAIT_V
#undef PG8_WAIT_L
#undef PG8_BAR
#undef PG8_SCHED
}

struct EpiZ {
    static constexpr bool PERM = true, AFTER_DRAIN = false;
    u16* Z; u16* VT; const float* rowss;
    DI void operator()(const f32x4 (&acc)[2][2][4][2], const Unit& u, int wr, int wc, int fr, int fq) const {
#pragma unroll
        for (int ai = 0; ai < 2; ++ai)
#pragma unroll
            for (int m = 0; m < 4; ++m) {
                const long row = (long)u.pm * 256 + 128 * ai + 64 * wr + 16 * m + fr;
                const float rs = rsqrtf(rowss[row] * (1.f / 1024.f) + EPS);
#pragma unroll
                for (int bj = 0; bj < 2; ++bj) {
                    const int c0 = u.pn * 256 + 128 * bj + 32 * wc + 8 * fq;
                    const f32x4 x = acc[ai][bj][m][0], y = acc[ai][bj][m][1];
                    u32x4 w = {cvtpk(x[0] * rs, x[1] * rs), cvtpk(x[2] * rs, x[3] * rs), cvtpk(y[0] * rs, y[1] * rs), cvtpk(y[2] * rs, y[3] * rs)};
                    *(u32x4*)(Z + row * ZLD + c0) = w;
                    if (c0 >= ZGV && c0 < ZGV + 256) {
                        u16* vp = VT + ((row >> 6) * 256 + (c0 - ZGV)) * 64 + (row & 63);
#pragma unroll
                        for (int j = 0; j < 4; ++j) { vp[(2 * j) * 64] = (u16)(w[j] & 0xffffu); vp[(2 * j + 1) * 64] = (u16)(w[j] >> 16); }
                    }
                }
            }
    }
};
struct EpiRes {
    static constexpr bool PERM = true, AFTER_DRAIN = false;
    float* out; const float* rp; const float* rsm; u16* xb; float* rowss;
    DI void operator()(const f32x4 (&acc)[2][2][4][2], const Unit& u, int wr, int wc, int fr, int fq) const {
#pragma unroll
        for (int ai = 0; ai < 2; ++ai)
#pragma unroll
            for (int m = 0; m < 4; ++m) {
                const long row = (long)u.pm * 256 + 128 * ai + 64 * wr + 16 * m + fr;
                const float* res = (row < NP ? rp : rsm) + row * 1024;
                float ssq = 0.f;
#pragma unroll
                for (int bj = 0; bj < 2; ++bj) {
                    const int c0 = u.pn * 256 + 128 * bj + 32 * wc + 8 * fq;
                    const f32x4 r0 = *(const f32x4*)(res + c0), r1 = *(const f32x4*)(res + c0 + 4);
                    f32x4 x = acc[ai][bj][m][0], y = acc[ai][bj][m][1];
#pragma unroll
                    for (int j = 0; j < 4; ++j) { x[j] += r0[j]; y[j] += r1[j]; ssq = fmaf(x[j], x[j], fmaf(y[j], y[j], ssq)); }
                    if (out) { *(f32x4*)(out + row * 1024 + c0) = x; *(f32x4*)(out + row * 1024 + c0 + 4) = y; }
                    if (xb) { u32x4 w = {cvtpk(x[0], x[1]), cvtpk(x[2], x[3]), cvtpk(y[0], y[1]), cvtpk(y[2], y[3])}; *(u32x4*)(xb + row * 1024 + c0) = w; }
                }
                if (rowss) { ssq += __shfl_xor(ssq, 16); ssq += __shfl_xor(ssq, 32); if (fq == 0) atomicAdd(rowss + row, ssq); }
            }
    }
};
}

DI void transpose_tile(const float* __restrict__ src, int ldsrc, int coloff, int N, int K, const float* __restrict__ gsc, u16* __restrict__ dst,
                       int kt, int nt, char* lds) {
  float* T = (float*)lds;
  const int tid = otid();
#pragma unroll
  for (int i = 0; i < 2; ++i) {
    const int kk = (tid >> 4) + 32 * i, n4 = (tid & 15) * 4, k = kt * 64 + kk, n = nt * 64 + n4;
    f32x4 v = {0.f, 0.f, 0.f, 0.f};
    if (n < N) v = *(const f32x4*)(src + (long)k * ldsrc + coloff + n);
    const float gs = gsc ? gsc[k] : 1.f;
    T[kk * 65 + n4 + 0] = v[0] * gs; T[kk * 65 + n4 + 1] = v[1] * gs; T[kk * 65 + n4 + 2] = v[2] * gs; T[kk * 65 + n4 + 3] = v[3] * gs;
  }
  __syncthreads();
  {
    const int n = tid >> 3, k8 = (tid & 7) * 8;
    u32x4 w;
    w[0] = cvtpk(T[(k8 + 0) * 65 + n], T[(k8 + 1) * 65 + n]); w[1] = cvtpk(T[(k8 + 2) * 65 + n], T[(k8 + 3) * 65 + n]);
    w[2] = cvtpk(T[(k8 + 4) * 65 + n], T[(k8 + 5) * 65 + n]); w[3] = cvtpk(T[(k8 + 6) * 65 + n], T[(k8 + 7) * 65 + n]);
    *(u32x4*)(dst + (long)(nt * 64 + n) * K + kt * 64 + k8) = w;
  }
  __syncthreads();
}

DI void phase_weights(const Params& p, char* lds) {
  const int nb = gridDim.x, bid = blockIdx.x;
  for (int it = bid; it < 2 * 864; it += nb) {
    const int l = it / 864; int t = it % 864;
    if (t < 576) { transpose_tile(p.w_in + (long)l * 1024 * INC, INC, 0, INC, 1024, p.norm_g + l * 1024, (u16*)(p.ws + OFF_WIN + l * SZ_WIN), t / 36, t % 36, lds); }
    else if ((t -= 576) < 256) { transpose_tile(p.w_out + (long)l * 1024 * 1024, 1024, 0, 1024, 1024, nullptr, (u16*)(p.ws + OFF_WOUT + l * SZ_WOUT), t >> 4, t & 15, lds); }
    else if ((t -= 256) < 16) { const int h = t >> 2; transpose_tile(p.w_ukv + (long)l * 128 * 1024, 1024, h * 256 + 128, 128, 128, nullptr,
                                                                     (u16*)(p.ws + OFF_WUV + l * SZ_WUV) + h * 128 * 128, (t >> 1) & 1, t & 1, lds); }
    else { t -= 16; const int h = t >> 2; transpose_tile(p.w_uq + (long)l * 256 * 768, 768, h * 192 + 128, 64, 256, p.q_norm_g + l * 256,
                                                         (u16*)(p.ws + OFF_WQ + l * SZ_WQ) + (h * 192 + 128) * 256, t & 3, 0, lds); }
  }
  const int nthr = nb * 512;
  for (int idx = bid * 512 + otid(); idx < 2 * 4 * 128 * 256; idx += nthr) {
    const int k = idx & 255, c = (idx >> 8) & 127, h = (idx >> 15) & 3, l = (int)(idx >> 17);
    const float* a = p.w_uq + (long)l * 256 * 768 + k * 768 + h * 192;
    const float* b = p.w_ukv + (long)l * 128 * 1024 + c * 1024 + h * 256;
    float s = 0.f;
    for (int e = 0; e < 128; e += 4) { const f32x4 x = *(const f32x4*)(a + e), y = *(const f32x4*)(b + e); s += x[0] * y[0] + x[1] * y[1] + x[2] * y[2] + x[3] * y[3]; }
    ((u16*)(p.ws + OFF_WQ + l * SZ_WQ))[(h * 192 + c) * 256 + k] = f2bf(s * p.q_norm_g[l * 256 + k]);
  }
  for (int idx = bid * 512 + otid(); idx < 8192 * 32; idx += nthr) {
    const int pos = (int)(idx >> 5), i = (int)(idx & 31);
    const float invf = exp2f(-(float)i * 0.41524101186092029f);
    const float ang = (float)pos * invf;
    const double x = (double)ang;
    const double kq = rint(x * 0.15915494309189535);
    const double r = fma(-kq, 6.283185307179586, x);
    const double r2 = r * r;
    double sn = r, tm = r, cn = 1.0, tc = 1.0;
#pragma unroll
    for (int n = 1; n <= 14; ++n) { tm *= -r2 * (1.0 / (double)((2 * n) * (2 * n + 1))); sn += tm; tc *= -r2 * (1.0 / (double)((2 * n - 1) * (2 * n))); cn += tc; }
    ((float2*)(p.ws + OFF_CS))[idx] = make_float2((float)cn, (float)sn);
  }
}

DI void phase_kbuild(const Params& p, int l) {
  const u16* Z = (const u16*)(p.ws + OFF_Z); u16* Kb = (u16*)(p.ws + OFF_K); const float* cs = (const float*)(p.ws + OFF_CS);
  const int tidk = otid(); const int lane = tidk & 63, j = lane & 7, sub = lane >> 3;
  const int wv = blockIdx.x * 8 + (tidk >> 6), nw = gridDim.x * 8;
  float g[16];
#pragma unroll
  for (int i = 0; i < 16; ++i) g[i] = p.kv_norm_g[l * 128 + j * 16 + i];
  for (int t0 = wv * 8; t0 < NTOK; t0 += nw * 8) {
    const long t = t0 + sub;
    const u16* zr = Z + t * ZLD;
    const bf16x8 a = *(const bf16x8*)(zr + ZKV + j * 16), b = *(const bf16x8*)(zr + ZKV + j * 16 + 8);
    const s16x4 x1v = *(const s16x4*)(zr + ZKR + 4 * j), x2v = *(const s16x4*)(zr + ZKR + 32 + 4 * j);
    const f32x8 c = *(const f32x8*)(cs + ((long)tok_pos((int)t) * 32 + 4 * j) * 2);
    float v[16]; float s = 0.f;
#pragma unroll
    for (int i = 0; i < 8; ++i) { v[i] = bf2f((u16)a[i]); v[8 + i] = bf2f((u16)b[i]); }
#pragma unroll
    for (int i = 0; i < 16; ++i) s = fmaf(v[i], v[i], s);
    s += __shfl_xor(s, 1); s += __shfl_xor(s, 2); s += __shfl_xor(s, 4);
    const float rs = rsqrtf(s * (1.f / 128.f) + EPS);
    u32x4 w0, w1;
#pragma unroll
    for (int i = 0; i < 4; ++i) { w0[i] = cvtpk(v[2 * i] * rs * g[2 * i], v[2 * i + 1] * rs * g[2 * i + 1]); w1[i] = cvtpk(v[8 + 2 * i] * rs * g[8 + 2 * i], v[9 + 2 * i] * rs * g[9 + 2 * i]); }
    u16* kr = Kb + t * 192;
    *(u32x4*)(kr + j * 16) = w0; *(u32x4*)(kr + j * 16 + 8) = w1;
    float o1[4], o2[4];
#pragma unroll
    for (int i = 0; i < 4; ++i) { const float x1 = bf2f((u16)x1v[i]), x2 = bf2f((u16)x2v[i]); o1[i] = x1 * c[2 * i] - x2 * c[2 * i + 1]; o2[i] = x2 * c[2 * i] + x1 * c[2 * i + 1]; }
    uint2 r1, r2; r1.x = cvtpk(o1[0], o1[1]); r1.y = cvtpk(o1[2], o1[3]); r2.x = cvtpk(o2[0], o2[1]); r2.y = cvtpk(o2[2], o2[3]);
    *(uint2*)(kr + 128 + 4 * j) = r1; *(uint2*)(kr + 160 + 4 * j) = r2;
  }
}

constexpr int SHM_GLA1 = 65536 + 32768 + 8192 + 1024;
DI void gla_local_chunk(const Params& p, int l, int chunk, char* lds) {
  const u16* Z = (const u16*)(p.ws + OFF_Z);
  float* G = (float*)lds; u16* V16 = (u16*)(lds + 65536); float* LR = (float*)(lds + 65536 + 32768); float* E = (float*)(lds + 65536 + 32768 + 8192);
  const int tid = otid(); const long t0 = (long)chunk * 64;
  __syncthreads();
  for (int i = tid; i < 64 * 32; i += 512) { const int t = i >> 5, r = i & 31; LR[i] = bf2f(Z[(t0 + t) * ZLD + ZLF + r]); }
  for (int i = tid; i < 64 * 32; i += 512) { const int t = i >> 5, c8 = (i & 31) * 8; *(bf16x8*)(V16 + t * 256 + c8) = *(const bf16x8*)(Z + (t0 + t) * ZLD + ZGV + c8); }
  __syncthreads();
  {
    const int col = tid & 255, dir = col >> 7, hd = col & 127, th = tid >> 8;
    const float* up = (dir ? p.gk_up_bwd : p.gk_up_fwd) + l * 16 * 128 + hd;
    const float bias = (dir ? p.gk_bias_bwd : p.gk_bias_fwd)[l * 128 + hd];
    float u[16];
#pragma unroll
    for (int r = 0; r < 16; ++r) u[r] = up[r * 128];
#pragma unroll 4
    for (int ii = 0; ii < 32; ++ii) {
      const int t = th * 32 + ii; float zz = bias;
#pragma unroll
      for (int r = 0; r < 16; ++r) zz = fmaf(LR[t * 32 + dir * 16 + r], u[r], zz);
      G[t * 256 + col] = logsig(zz) * (1.f / 16.f);
    }
  }
  __syncthreads();
  if (tid < 256) {
    float* GC = (float*)(p.ws + OFF_GC);
    float gv[64];
#pragma unroll
    for (int t = 0; t < 64; ++t) gv[t] = G[t * 256 + tid];
    float s = 0.f;
    if (tid < 128) {
#pragma unroll
      for (int t = 0; t < 64; ++t) { s += gv[t]; gv[t] = s; }
    } else {
#pragma unroll
      for (int t = 63; t >= 0; --t) { s += gv[t]; gv[t] = s; }
    }
#pragma unroll
    for (int t = 0; t < 64; ++t) { G[t * 256 + tid] = gv[t]; GC[(t0 + t) * 256 + tid] = gv[t]; }
    E[tid] = s;
    const int dir = tid >> 7, hd = tid & 127;
    ((float*)(p.ws + OFF_DK))[((long)dir * NCHUNK + chunk) * 128 + hd] = __expf(s);
  }
  __syncthreads();
#pragma unroll 8
  for (int i = tid; i < 64 * 256; i += 512) { const int t = i >> 8, col = i & 255, hd = col & 127;
    const float k = bf2f(Z[(t0 + t) * ZLD + ZGK + hd]); G[i] = k * __expf(E[col] - G[i]); }
  __syncthreads();
  {
    const int combo = tid >> 6, dir = combo >> 2, h = combo & 3, lane = tid & 63, d0 = (lane >> 3) * 4, e0 = (lane & 7) * 8;
    float acc[4][8];
#pragma unroll
    for (int a = 0; a < 4; ++a)
#pragma unroll
      for (int b = 0; b < 8; ++b) acc[a][b] = 0.f;
#pragma unroll 4
    for (int j = 0; j < 64; ++j) {
      const f32x4 kq = *(const f32x4*)(G + j * 256 + dir * 128 + h * 32 + d0);
      const bf16x8 vv = *(const bf16x8*)(V16 + j * 256 + h * 64 + e0);
#pragma unroll
      for (int b = 0; b < 8; ++b) { const float vf = bf2f((u16)vv[b]);
#pragma unroll
        for (int a = 0; a < 4; ++a) acc[a][b] = fmaf(kq[a], vf, acc[a][b]); }
    }
    float* L = (float*)(p.ws + OFF_LST) + (((long)dir * NCHUNK + chunk) * 4 + h) * 2048;
#pragma unroll
    for (int b = 0; b < 8; ++b) *(f32x4*)(L + (e0 + b) * 32 + d0) = f32x4{acc[0][b], acc[1][b], acc[2][b], acc[3][b]};
  }
}

constexpr int GLW_UPT = 0, GLW_BIAS = 16384, GLW_KT = 17408, GLW_KT_SZ = 9216, SHM_GLW = GLW_KT + 8 * GLW_KT_SZ;
DI void glw_stage(const Params& p, int l, char* lds) {
  float* UPT = (float*)(lds + GLW_UPT); float* BI = (float*)(lds + GLW_BIAS);
  const int tid = otid();
  for (int i = tid; i < 2 * 16 * 128; i += 512) { const int dir = i >> 11, r = (i >> 7) & 15, hd = i & 127;
    UPT[(dir * 128 + hd) * 16 + r] = (dir ? p.gk_up_bwd : p.gk_up_fwd)[l * 2048 + r * 128 + hd]; }
  if (tid < 256) BI[tid] = (tid < 128 ? p.gk_bias_fwd : p.gk_bias_bwd)[l * 128 + (tid & 127)];
}
DI void gla_local_wave(const Params& p, int l, int task, char* lds) {
  const u16* Z = (const u16*)(p.ws + OFF_Z); const u16* VT = (const u16*)(p.ws + OFF_VT);
  const float* UPT = (const float*)(lds + GLW_UPT); const float* BI = (const float*)(lds + GLW_BIAS);
  const int chunk = task >> 2, h = task & 3; const long t0 = (long)chunk * 64;
  const int tid = otid(), wid = tid >> 6, lane = tid & 63, r32 = lane & 31, hi = lane >> 5;
  char* KT = lds + GLW_KT + wid * GLW_KT_SZ;
  const long tok = t0 + lane;
  float lr[32], kf[32];
  { const bf16x8 a0 = *(const bf16x8*)(Z + tok * ZLD + ZLF), a1 = *(const bf16x8*)(Z + tok * ZLD + ZLF + 8), a2 = *(const bf16x8*)(Z + tok * ZLD + ZLF + 16), a3 = *(const bf16x8*)(Z + tok * ZLD + ZLF + 24);
    const bf16x8 k0 = *(const bf16x8*)(Z + tok * ZLD + ZGK + h * 32), k1 = *(const bf16x8*)(Z + tok * ZLD + ZGK + h * 32 + 8), k2 = *(const bf16x8*)(Z + tok * ZLD + ZGK + h * 32 + 16), k3 = *(const bf16x8*)(Z + tok * ZLD + ZGK + h * 32 + 24);
#pragma unroll
    for (int j = 0; j < 8; ++j) { lr[j] = bf2f((u16)a0[j]); lr[8 + j] = bf2f((u16)a1[j]); lr[16 + j] = bf2f((u16)a2[j]); lr[24 + j] = bf2f((u16)a3[j]);
      kf[j] = bf2f((u16)k0[j]); kf[8 + j] = bf2f((u16)k1[j]); kf[16 + j] = bf2f((u16)k2[j]); kf[24 + j] = bf2f((u16)k3[j]); } }
  float* GC = (float*)(p.ws + OFF_GC); float* DK = (float*)(p.ws + OFF_DK);
#pragma unroll
  for (int dir = 0; dir < 2; ++dir) {
    float cum[32];
#pragma unroll
    for (int d = 0; d < 32; ++d) {
      const float* up = UPT + (dir * 128 + h * 32 + d) * 16;
      const f32x4 u0 = *(const f32x4*)up, u1 = *(const f32x4*)(up + 4), u2 = *(const f32x4*)(up + 8), u3 = *(const f32x4*)(up + 12);
      float zz = BI[dir * 128 + h * 32 + d];
#pragma unroll
      for (int r = 0; r < 4; ++r) { zz = fmaf(lr[dir * 16 + r], u0[r], zz); zz = fmaf(lr[dir * 16 + 4 + r], u1[r], zz); zz = fmaf(lr[dir * 16 + 8 + r], u2[r], zz); zz = fmaf(lr[dir * 16 + 12 + r], u3[r], zz); }
      float g = logsig(zz) * (1.f / 16.f);
#pragma unroll
      for (int o = 1; o < 64; o <<= 1) { const float nb2 = dir ? __shfl_down(g, o) : __shfl_up(g, o); const bool ok = dir ? (lane + o < 64) : (lane >= o); g += ok ? nb2 : 0.f; }
      cum[d] = g;
    }
    float* gp = GC + tok * 256 + dir * 128 + h * 32;
#pragma unroll
    for (int d4 = 0; d4 < 8; ++d4) *(f32x4*)(gp + d4 * 4) = f32x4{cum[d4 * 4], cum[d4 * 4 + 1], cum[d4 * 4 + 2], cum[d4 * 4 + 3]};
#pragma unroll
    for (int d = 0; d < 32; ++d) {
      const float E = __shfl(cum[d], dir ? 0 : 63);
      if (lane == d) DK[((long)dir * NCHUNK + chunk) * 128 + h * 32 + d] = __expf(E);
      const float kp = kf[d] * __expf(E - cum[d]);
      *(u16*)(KT + (dir * 32 + d) * 144 + lane * 2) = f2bf(kp);
    }
  }
  bf16x8 vf[2][4];
#pragma unroll
  for (int et = 0; et < 2; ++et)
#pragma unroll
    for (int s4 = 0; s4 < 4; ++s4) vf[et][s4] = *(const bf16x8*)(VT + ((long)chunk * 256 + h * 64 + et * 32 + r32) * 64 + 16 * s4 + 8 * hi);
  asm volatile("s_waitcnt lgkmcnt(0)" ::: "memory");
#pragma unroll
  for (int dir = 0; dir < 2; ++dir) {
    f32x16 acc[2];
#pragma unroll
    for (int et = 0; et < 2; ++et)
#pragma unroll
      for (int r = 0; r < 16; ++r) acc[et][r] = 0.f;
#pragma unroll
    for (int s4 = 0; s4 < 4; ++s4) {
      const bf16x8 kb = *(const bf16x8*)(KT + (dir * 32 + r32) * 144 + (16 * s4 + 8 * hi) * 2);
      acc[0] = MFMA32(vf[0][s4], kb, acc[0]); acc[1] = MFMA32(vf[1][s4], kb, acc[1]);
    }
    float* L = (float*)(p.ws + OFF_LST) + (((long)dir * NCHUNK + chunk) * 4 + h) * 2048;
#pragma unroll
    for (int et = 0; et < 2; ++et)
#pragma unroll
      for (int r = 0; r < 16; ++r) L[(et * 32 + crow(r, hi)) * 32 + r32] = acc[et][r];
  }
}

DI void phase_gla_scan(const Params& p) {
  float* LST = (float*)(p.ws + OFF_LST); const float* DK = (const float*)(p.ws + OFF_DK);
  const long gt = (long)blockIdx.x * 512 + otid(), nthr = (long)gridDim.x * 512;
  for (long pid = gt; pid < 96L * 1024; pid += nthr) {
    const int sid = (int)(pid >> 10), within = (int)(pid & 1023), e = within >> 4, d = (within & 15) * 2;
    const int dir = sid / 48, r = sid % 48;
    int b, h, c0, n;
    if (r < 32) { b = r >> 2; h = r & 3; c0 = b * 128; n = 128; } else { b = (r - 32) >> 2; h = r & 3; c0 = 1024 + b * 64; n = 64; }
    float2 S = make_float2(0.f, 0.f);
    for (int i0 = 0; i0 < n; i0 += 8) {
      float2 Lv[8]; float2 Dv[8];
#pragma unroll
      for (int u = 0; u < 8; ++u) { const int ch = dir ? (c0 + n - 1 - (i0 + u)) : (c0 + i0 + u);
        Lv[u] = *(const float2*)(LST + (((long)dir * NCHUNK + ch) * 4 + h) * 2048 + e * 32 + d);
        Dv[u] = *(const float2*)(DK + ((long)dir * NCHUNK + ch) * 128 + h * 32 + d); }
#pragma unroll
      for (int u = 0; u < 8; ++u) { const int ch = dir ? (c0 + n - 1 - (i0 + u)) : (c0 + i0 + u);
        *(float2*)(LST + (((long)dir * NCHUNK + ch) * 4 + h) * 2048 + e * 32 + d) = S;
        S.x = fmaf(Dv[u].x, S.x, Lv[u].x); S.y = fmaf(Dv[u].y, S.y, Lv[u].y); }
    }
  }
}

constexpr int SHM_GLA2 = 0;
DI void gla_out_wave(const Params& p, int l, int task) {
  const u16* Z = (const u16*)(p.ws + OFF_Z); const float* GC = (const float*)(p.ws + OFF_GC); u16* MIX = (u16*)(p.ws + OFF_MIX);
  const u16* VT = (const u16*)(p.ws + OFF_VT); const float* LST = (const float*)(p.ws + OFF_LST);
  const int chunk = task >> 2, h = task & 3; const long t0 = (long)chunk * 64;
  const int lane = otid() & 63, r32 = lane & 31, hi = lane >> 5;
  bf16x8 QEf[2][2], QEb[2][2], KEf[2][2], KEb[2][2];
#pragma unroll
  for (int t = 0; t < 2; ++t)
#pragma unroll
    for (int sdx = 0; sdx < 2; ++sdx) {
      const long tok = t0 + t * 32 + r32; const int d0 = 16 * sdx + 8 * hi;
      const bf16x8 qv = *(const bf16x8*)(Z + tok * ZLD + ZGQ + h * 32 + d0), kv = *(const bf16x8*)(Z + tok * ZLD + ZGK + h * 32 + d0);
      const f32x8 bv = *(const f32x8*)(GC + tok * 256 + h * 32 + d0), cv = *(const f32x8*)(GC + tok * 256 + 128 + h * 32 + d0);
      f32x8 a, b, c, d;
#pragma unroll
      for (int j = 0; j < 8; ++j) { const float q = bf2f((u16)qv[j]) * 0.17677669529663687f, k = bf2f((u16)kv[j]);
        const float eb = __expf(bv[j]), ec = __expf(cv[j]);
        a[j] = q * eb; b[j] = k * __builtin_amdgcn_rcpf(eb); c[j] = q * ec; d[j] = k * __builtin_amdgcn_rcpf(ec); }
      QEf[t][sdx] = cvt8(a); KEf[t][sdx] = cvt8(b); QEb[t][sdx] = cvt8(c); KEb[t][sdx] = cvt8(d);
    }
  bf16x8 VTf[2][4];
#pragma unroll
  for (int et = 0; et < 2; ++et)
#pragma unroll
    for (int s4 = 0; s4 < 4; ++s4) {
      const u16* vr = VT + ((long)chunk * 256 + h * 64 + et * 32 + r32) * 64 + 16 * s4 + 4 * hi;
      const s16x4 lo = *(const s16x4*)vr, up = *(const s16x4*)(vr + 8);
      VTf[et][s4] = (bf16x8){lo[0], lo[1], lo[2], lo[3], up[0], up[1], up[2], up[3]};
    }
  f32x16 o[2][2];
#pragma unroll
  for (int et = 0; et < 2; ++et)
#pragma unroll
    for (int it = 0; it < 2; ++it)
#pragma unroll
      for (int r = 0; r < 16; ++r) o[et][it][r] = 0.f;
#pragma unroll
  for (int it = 0; it < 2; ++it) {
    bf16x8 PB[2][2];
#pragma unroll
    for (int jt = 0; jt < 2; ++jt) {
      f32x16 af, ab;
#pragma unroll
      for (int r = 0; r < 16; ++r) { af[r] = 0.f; ab[r] = 0.f; }
      if (jt <= it) { af = MFMA32(KEf[jt][0], QEf[it][0], af); af = MFMA32(KEf[jt][1], QEf[it][1], af); }
      if (jt >= it) { ab = MFMA32(KEb[jt][0], QEb[it][0], ab); ab = MFMA32(KEb[jt][1], QEb[it][1], ab); }
      f32x16 a;
      if (jt < it) a = af; else if (jt > it) a = ab;
      else {
#pragma unroll
        for (int r = 0; r < 16; ++r) { const int jl = crow(r, hi); a[r] = (jl < r32) ? af[r] : ((jl > r32) ? ab[r] : af[r] + ab[r]); }
      }
      PB[jt][0] = pack8(a, 0); PB[jt][1] = pack8(a, 1);
    }
#pragma unroll
    for (int et = 0; et < 2; ++et)
#pragma unroll
      for (int s4 = 0; s4 < 4; ++s4) o[et][it] = MFMA32(VTf[et][s4], PB[s4 >> 1][s4 & 1], o[et][it]);
  }
#pragma unroll
  for (int dir = 0; dir < 2; ++dir)
#pragma unroll
    for (int et = 0; et < 2; ++et)
#pragma unroll
      for (int sdx = 0; sdx < 2; ++sdx) {
        const float* sp = LST + (((long)dir * NCHUNK + chunk) * 4 + h) * 2048 + (et * 32 + r32) * 32 + 16 * sdx + 8 * hi;
        const bf16x8 sf = cvt8(*(const f32x8*)sp);
#pragma unroll
        for (int it = 0; it < 2; ++it) o[et][it] = MFMA32(sf, dir ? QEb[it][sdx] : QEf[it][sdx], o[et][it]);
      }
#pragma unroll
  for (int it = 0; it < 2; ++it) {
    const long tok = t0 + it * 32 + r32;
    float ssq = 0.f;
#pragma unroll
    for (int et = 0; et < 2; ++et)
#pragma unroll
      for (int r = 0; r < 16; ++r) ssq = fmaf(o[et][it][r], o[et][it][r], ssq);
    ssq += __shfl_xor(ssq, 32);
    const float rs = rsqrtf(ssq * (1.f / 64.f) + EPS);
#pragma unroll
    for (int et = 0; et < 2; ++et)
#pragma unroll
      for (int q = 0; q < 4; ++q) {
        const int e0 = et * 32 + 8 * q + 4 * hi;
        const s16x4 gt = *(const s16x4*)(Z + tok * ZLD + ZGG + h * 64 + e0);
        const f32x4 gn = *(const f32x4*)(p.gla_norm_g + l * 64 + e0);
        float v[4];
#pragma unroll
        for (int j = 0; j < 4; ++j) v[j] = o[et][it][4 * q + j] * rs * gn[j] * silu(bf2f((u16)gt[j]));
        uint2 w; w.x = cvtpk(v[0], v[1]); w.y = cvtpk(v[2], v[3]);
        *(uint2*)(MIX + tok * 1024 + 768 + h * 64 + e0) = w;
      }
  }
}

template <int HALF> DI void pool_window(const u16* U, float* P, int c, int th, int s0, int SL) {
  float v[32 + 2 * HALF];
#pragma unroll
  for (int k = 0; k < 32 + 2 * HALF; ++k) v[k] = bf2f(U[(th * 32 + 8 - HALF + k) * 256 + c]);
  float run = 0.f;
#pragma unroll
  for (int k = 0; k < 2 * HALF; ++k) run += v[k];
#pragma unroll
  for (int ii = 0; ii < 32; ++ii) {
    const int i = th * 32 + ii, s = s0 + i, lo = max(s - HALF, 0), hi = min(s + HALF, SL);
    P[i * 256 + c] = run / (float)(hi - lo) - v[ii + HALF];
    if (ii < 31) run += v[ii + 2 * HALF] - v[ii];
  }
}
constexpr int SHM_POOL = 40960 + 65536;
DI void pool_chunk(const Params& p, int l, int chunk, char* lds) {
  const u16* Z = (const u16*)(p.ws + OFF_Z); u16* MIX = (u16*)(p.ws + OFF_MIX);
  u16* U = (u16*)lds; float* P = (float*)(lds + 40960);
  const int tid = otid();
  long tokbase; int s0, SL;
  if (chunk < 1024) { tokbase = (long)(chunk >> 7) * 8192; s0 = (chunk & 127) * 64; SL = 8192; }
  else { const int c = chunk - 1024; tokbase = NP + (long)(c >> 6) * 4096; s0 = (c & 63) * 64; SL = 4096; }
  __syncthreads();
  for (int i = tid; i < 80 * 32; i += 512) { const int r = i >> 5, c8 = (i & 31) * 8, s = s0 - 8 + r;
    bf16x8 v = {0, 0, 0, 0, 0, 0, 0, 0};
    if (s >= 0 && s < SL) v = *(const bf16x8*)(Z + (tokbase + s) * ZLD + ZUP + c8);
    *(bf16x8*)(U + r * 256 + c8) = v; }
  __syncthreads();
  { const int c = tid & 255, th = tid >> 8, gi = c >> 6;
    if (gi == 0) pool_window<1>(U, P, c, th, s0, SL); else if (gi == 1) pool_window<2>(U, P, c, th, s0, SL);
    else if (gi == 2) pool_window<4>(U, P, c, th, s0, SL); else pool_window<8>(U, P, c, th, s0, SL);
  }
  __syncthreads();
  { const int n = tid & 255, gi = n >> 6, d = n & 63, th = tid >> 8;
    const float* W = p.w_pool + (long)l * 4 * 64 * 64 + gi * 4096 + d;
    float acc[32];
#pragma unroll
    for (int ii = 0; ii < 32; ++ii) acc[ii] = 0.f;
    float wreg[64];
#pragma unroll
    for (int c = 0; c < 64; ++c) wreg[c] = W[c * 64];
#pragma unroll
    for (int c4 = 0; c4 < 16; ++c4) {
      const float w0 = wreg[c4 * 4 + 0], w1 = wreg[c4 * 4 + 1], w2 = wreg[c4 * 4 + 2], w3 = wreg[c4 * 4 + 3];
#pragma unroll
      for (int ii = 0; ii < 32; ++ii) { const f32x4 pv = *(const f32x4*)(P + (th * 32 + ii) * 256 + gi * 64 + c4 * 4);
        acc[ii] = fmaf(pv[0], w0, fmaf(pv[1], w1, fmaf(pv[2], w2, fmaf(pv[3], w3, acc[ii])))); }
    }
    const float sc = p.pool_scale[l * 256 + n];
#pragma unroll
    for (int ii = 0; ii < 32; ++ii) { const long t = (long)chunk * 64 + th * 32 + ii;
      const float g = bf2f(Z[t * ZLD + ZGP + n]);
      MIX[t * 1024 + 512 + n] = f2bf(acc[ii] * sc * silu(g)); }
  }
}

constexpr int KVBLK = 64;
constexpr int SHM_K = 64 * 384, SHM_V = 64 * 256;
constexpr int SHM_ATTN = 2 * SHM_V + 2 * SHM_K + 8 * 64 * 4;
constexpr float THR = 8.f;
#define KSWZ(row, colB) ((row) * 384 + ((colB) ^ ((((row) >> 1) & 7) << 4)))
DI void partialSM(f32x16& p0, f32x16& p1, float& m_reg, float& mn, float& alpha) {
  constexpr float C = MLA_SCALE * 1.4426950408889634f;
  float pmax = p0[0];
#pragma unroll
  for (int r = 1; r < 16; ++r) pmax = fmaxf(pmax, p0[r]);
#pragma unroll
  for (int r = 0; r < 16; ++r) pmax = fmaxf(pmax, p1[r]);
  { auto rr = __builtin_amdgcn_permlane32_swap(__float_as_uint(pmax), __float_as_uint(pmax), false, false);
    pmax = fmaxf(__uint_as_float(rr[0]), __uint_as_float(rr[1])); }
  if (__builtin_expect(__all(pmax - m_reg <= THR / MLA_SCALE), 1)) { mn = m_reg; alpha = 1.f; }
  else { mn = fmaxf(m_reg, pmax); alpha = __builtin_amdgcn_exp2f((m_reg - mn) * C); m_reg = mn; }
  const float mnC = -mn * C;
#pragma unroll
  for (int r = 0; r < 16; ++r) p0[r] = fmaf(p0[r], C, mnC);
#pragma unroll
  for (int r = 0; r < 16; ++r) p1[r] = fmaf(p1[r], C, mnC);
#pragma unroll
  for (int r = 0; r < 16; ++r) p0[r] = __builtin_amdgcn_exp2f(p0[r]);
}
DI void finishSM(f32x16& p0, f32x16& p1, float alpha, float& l_reg, bf16x8& pa0, bf16x8& pa1, bf16x8& pa2, bf16x8& pa3) {
#pragma unroll
  for (int r = 0; r < 16; ++r) p1[r] = __builtin_amdgcn_exp2f(p1[r]);
  float ps = 0;
#pragma unroll
  for (int r = 0; r < 16; ++r) ps += p0[r];
#pragma unroll
  for (int r = 0; r < 16; ++r) ps += p1[r];
  { auto rr = __builtin_amdgcn_permlane32_swap(__float_as_uint(ps), __float_as_uint(ps), false, false);
    ps = __uint_as_float(rr[0]) + __uint_as_float(rr[1]); }
  l_reg = l_reg * alpha + ps;
#define PK4(P, BASE, OUT) do { unsigned a0 = cvtpkv(P[BASE + 0], P[BASE + 1]), a1 = cvtpkv(P[BASE + 2], P[BASE + 3]);   \
    unsigned b0 = cvtpkv(P[BASE + 4], P[BASE + 5]), b1 = cvtpkv(P[BASE + 6], P[BASE + 7]);                              \
    auto r0 = __builtin_amdgcn_permlane32_swap(a0, b0, false, false); auto r1 = __builtin_amdgcn_permlane32_swap(a1, b1, false, false); \
    u32x4 w = {r0[0], r1[0], r0[1], r1[1]}; OUT = __builtin_bit_cast(bf16x8, w); } while (0)
  PK4(p0, 0, pa0); PK4(p0, 8, pa1); PK4(p1, 0, pa2); PK4(p1, 8, pa3);
#undef PK4
}
DI void qkt(f32x16& p0, f32x16& p1, const char* Ks, const bf16x8* qr, int kb0) {
#pragma unroll
  for (int r = 0; r < 16; ++r) { p0[r] = 0.f; p1[r] = 0.f; }
  __builtin_amdgcn_s_setprio(1);
  int kq = kb0; asm volatile("" : "+v"(kq));
#pragma unroll
  for (int d0 = 0; d0 < 12; ++d0) { const int kb = kq ^ ((d0 & 3) << 5);
    const char* pk = Ks + kb + (d0 >> 2) * 128;
    bf16x8 b0 = *(const bf16x8*)(pk);
    bf16x8 b1 = *(const bf16x8*)(pk + 32 * 384);
    p0 = __builtin_amdgcn_mfma_f32_32x32x16_bf16(b0, qr[d0], p0, 0, 0, 0);
    p1 = __builtin_amdgcn_mfma_f32_32x32x16_bf16(b1, qr[d0], p1, 0, 0, 0); }
  __builtin_amdgcn_s_setprio(0);
}
DI int v_st(int k, int c) { const int kk = (k & ~0xC) | ((k & 4) << 1) | ((k & 8) >> 1); return ((kk >> 3) * 4 + (c >> 5)) * 512 + ((kk & 7) * 32 + (c & 31)) * 2; }
DI int v_rd_base(int lane) { return ((lane & 3) << 3) | (((lane >> 2) & 3) << 6) | (((lane >> 4) & 1) << 5) | (((lane >> 5) & 1) << 8); }
constexpr int v_rd_off(int d0, int ks, int half) { return d0 * 512 + ks * 4096 + half * 2048; }
template <int OFF> DI s16x4 tr_read(int vb) {
  s16x4 r; asm volatile("ds_read_b64_tr_b16 %0, %1 offset:%2" : "=&v"(r) : "v"(vb), "i"(OFF) : "memory"); return r;
}
template <int D0> DI void pv_one(f32x16& od, int vb, bf16x8 pa0, bf16x8 pa1, bf16x8 pa2, bf16x8 pa3) {
  const s16x4 l0 = tr_read<v_rd_off(D0, 0, 0)>(vb), h0 = tr_read<v_rd_off(D0, 0, 1)>(vb), l1 = tr_read<v_rd_off(D0, 1, 0)>(vb), h1 = tr_read<v_rd_off(D0, 1, 1)>(vb);
  const s16x4 l2 = tr_read<v_rd_off(D0, 2, 0)>(vb), h2 = tr_read<v_rd_off(D0, 2, 1)>(vb), l3 = tr_read<v_rd_off(D0, 3, 0)>(vb), h3 = tr_read<v_rd_off(D0, 3, 1)>(vb);
  asm volatile("s_waitcnt lgkmcnt(0)" ::: "memory"); SBAR();
  __builtin_amdgcn_s_setprio(1);
#define PK(L, H) (bf16x8){L[0], L[1], L[2], L[3], H[0], H[1], H[2], H[3]}
  od = __builtin_amdgcn_mfma_f32_32x32x16_bf16(PK(l0, h0), pa0, od, 0, 0, 0);
  od = __builtin_amdgcn_mfma_f32_32x32x16_bf16(PK(l1, h1), pa1, od, 0, 0, 0);
  od = __builtin_amdgcn_mfma_f32_32x32x16_bf16(PK(l2, h2), pa2, od, 0, 0, 0);
  od = __builtin_amdgcn_mfma_f32_32x32x16_bf16(PK(l3, h3), pa3, od, 0, 0, 0);
#undef PK
  __builtin_amdgcn_s_setprio(0);
}
DI void pv_d0(f32x16* o, int vb, bf16x8 pa0, bf16x8 pa1, bf16x8 pa2, bf16x8 pa3) {
  pv_one<0>(o[0], vb, pa0, pa1, pa2, pa3); pv_one<1>(o[1], vb, pa0, pa1, pa2, pa3); pv_one<2>(o[2], vb, pa0, pa1, pa2, pa3); pv_one<3>(o[3], vb, pa0, pa1, pa2, pa3);
}

DI void attn_body(const u16* __restrict__ Qb, const u16* __restrict__ Kh, const u16* __restrict__ Wuv, const u16* __restrict__ Gp, u16* __restrict__ Mx, int seq, char* lds) {
  const int tid = otid(), wid = tid >> 6, lane = tid & 63, r32 = lane & 31, hi = lane >> 5;
  char* V_lds = lds; char* K_lds = lds + 2 * SHM_V;
  float m_reg = -1e30f, l_reg = 0; f32x16 o[4]; bf16x8 qr[12];
#pragma unroll
  for (int d = 0; d < 4; ++d)
#pragma unroll
    for (int r = 0; r < 16; ++r) o[d][r] = 0.f;
  const u16* Qw = Qb + (long)(wid * 32 + r32) * 768 + hi * 8;
#pragma unroll
  for (int d0 = 0; d0 < 12; ++d0) qr[d0] = *(const bf16x8*)(Qw + d0 * 16);
  const int sr = tid >> 4, sc = (tid & 15) * 8, vst0 = v_st(sr, sc);
  const int rr = tid >> 3, rcB = 256 + (tid & 7) * 16;
  const int kst0 = KSWZ(sr, sc * 2), kst2 = KSWZ(rr, rcB);
  const int vb0 = (int)(uintptr_t)V_lds + v_rd_base(lane);
  const int kswz = (r32 >> 1) & 7;
  const int kb0 = r32 * 384 + (((0 + hi) ^ kswz) << 4);
  bf16x8 sA0, sA1, sA2, sB0, sB1, sB2;
#define SLOADE(k0) do { sA0 = *(const bf16x8*)(Kh + (long)((k0) + sr) * 192 + sc); sA1 = *(const bf16x8*)(Kh + (long)((k0) + 32 + sr) * 192 + sc); \
    sA2 = *(const bf16x8*)(Kh + (long)((k0) + rr) * 192 + 128 + (tid & 7) * 8); } while (0)
#define SLOADO(k0) do { sB0 = *(const bf16x8*)(Kh + (long)((k0) + sr) * 192 + sc); sB1 = *(const bf16x8*)(Kh + (long)((k0) + 32 + sr) * 192 + sc); \
    sB2 = *(const bf16x8*)(Kh + (long)((k0) + rr) * 192 + 128 + (tid & 7) * 8); } while (0)
#define SWRITE(b, x0, x1, x2) do { *(bf16x8*)(V_lds + (b) * SHM_V + vst0) = x0; *(bf16x8*)(V_lds + (b) * SHM_V + vst0 + 8192) = x1;   \
    *(bf16x8*)(K_lds + (b) * SHM_K + kst0) = x0; *(bf16x8*)(K_lds + (b) * SHM_K + kst0 + 32 * 384) = x1; *(bf16x8*)(K_lds + (b) * SHM_K + kst2) = x2; } while (0)
#define SWAIT() asm volatile("s_waitcnt vmcnt(3)" ::: "memory")
#define RESC(a) do { if (__any((a) < 1.f)) { _Pragma("unroll") for (int d = 0; d < 4; ++d) _Pragma("unroll") for (int r = 0; r < 16; ++r) o[d][r] *= (a); } } while (0)
  f32x16 pA0, pA1, pB0, pB1; float mnA, mnB, alA, alB; bf16x8 pa0, pa1, pa2, pa3; const int NT = seq / KVBLK;
  SLOADE(0); asm volatile("s_waitcnt vmcnt(0)" ::: "memory"); SWRITE(0, sA0, sA1, sA2); __syncthreads();
  qkt(pA0, pA1, K_lds, qr, kb0); partialSM(pA0, pA1, m_reg, mnA, alA);
  SLOADO(KVBLK); SLOADE(2 * KVBLK);
  SWAIT(); SWRITE(1, sB0, sB1, sB2); __syncthreads();
  for (int j = 1; j + 1 < NT; j += 2) {
    SBAR(); qkt(pB0, pB1, K_lds + SHM_K, qr, kb0);
    finishSM(pA0, pA1, alA, l_reg, pa0, pa1, pa2, pa3); SBAR();
    SLOADO((j + 2) * KVBLK); SBAR();
    pv_d0(o, vb0, pa0, pa1, pa2, pa3); partialSM(pB0, pB1, m_reg, mnB, alB);
    __syncthreads(); SWAIT(); SWRITE(0, sA0, sA1, sA2);
    RESC(alB); __syncthreads();
    SBAR(); qkt(pA0, pA1, K_lds, qr, kb0);
    finishSM(pB0, pB1, alB, l_reg, pa0, pa1, pa2, pa3); SBAR();
    SLOADE(min(j + 3, NT - 1) * KVBLK); SBAR();
    pv_d0(o, vb0 + SHM_V, pa0, pa1, pa2, pa3); partialSM(pA0, pA1, m_reg, mnA, alA);
    __syncthreads(); SWAIT(); SWRITE(1, sB0, sB1, sB2);
    RESC(alA); __syncthreads();
  }
  SBAR(); qkt(pB0, pB1, K_lds + SHM_K, qr, kb0);
  finishSM(pA0, pA1, alA, l_reg, pa0, pa1, pa2, pa3); SBAR();
  pv_d0(o, vb0, pa0, pa1, pa2, pa3); partialSM(pB0, pB1, m_reg, mnB, alB);
  __syncthreads(); RESC(alB);
  finishSM(pB0, pB1, alB, l_reg, pa0, pa1, pa2, pa3); SBAR();
  pv_d0(o, vb0 + SHM_V, pa0, pa1, pa2, pa3);
  {
    const bf16x8 wl0 = *(const bf16x8*)(Wuv + (tid >> 2) * 128 + ((tid & 3) * 4 + 0) * 8), wl1 = *(const bf16x8*)(Wuv + (tid >> 2) * 128 + ((tid & 3) * 4 + 1) * 8);
    const bf16x8 wl2 = *(const bf16x8*)(Wuv + (tid >> 2) * 128 + ((tid & 3) * 4 + 2) * 8), wl3 = *(const bf16x8*)(Wuv + (tid >> 2) * 128 + ((tid & 3) * 4 + 3) * 8);
    const float rl = __builtin_amdgcn_rcpf(l_reg);
#pragma unroll
    for (int d = 0; d < 4; ++d)
#pragma unroll
      for (int r = 0; r < 16; ++r) o[d][r] *= rl;
    __syncthreads();
    { char* wrow = lds + (tid >> 2) * 264 + (tid & 3) * 64;
#define W8(off, v) do { *(s16x4*)(wrow + (off)) = (s16x4){v[0], v[1], v[2], v[3]}; *(s16x4*)(wrow + (off) + 8) = (s16x4){v[4], v[5], v[6], v[7]}; } while (0)
      W8(0, wl0); W8(16, wl1); W8(32, wl2); W8(48, wl3);
#undef W8
    }
    __syncthreads();
    f32x16 u2[4];
#pragma unroll
    for (int et = 0; et < 4; ++et)
#pragma unroll
      for (int r = 0; r < 16; ++r) u2[et][r] = 0.f;
#pragma unroll
    for (int s8 = 0; s8 < 8; ++s8) {
      const bf16x8 bfr = pack8(o[s8 >> 1], s8 & 1);
#pragma unroll
      for (int et = 0; et < 4; ++et) {
        const char* wp = lds + (et * 32 + r32) * 264 + (16 * s8 + 4 * hi) * 2;
        const s16x4 lo = *(const s16x4*)wp, up = *(const s16x4*)(wp + 16);
        const bf16x8 af = (bf16x8){lo[0], lo[1], lo[2], lo[3], up[0], up[1], up[2], up[3]};
        u2[et] = MFMA32(af, bfr, u2[et]);
      }
    }
    const long trow = wid * 32 + r32;
#pragma unroll
    for (int et = 0; et < 4; ++et)
#pragma unroll
      for (int q = 0; q < 4; ++q) {
        const int e0 = et * 32 + 8 * q + 4 * hi;
        const uint2 g = *(const uint2*)(Gp + trow * ZLD + e0);
        const float v0 = u2[et][4 * q + 0] * silu(__uint_as_float(g.x << 16)), v1 = u2[et][4 * q + 1] * silu(__uint_as_float(g.x & 0xffff0000u));
        const float v2 = u2[et][4 * q + 2] * silu(__uint_as_float(g.y << 16)), v3 = u2[et][4 * q + 3] * silu(__uint_as_float(g.y & 0xffff0000u));
        uint2 w; w.x = cvtpk(v0, v1); w.y = cvtpk(v2, v3);
        *(uint2*)(Mx + trow * 1024 + e0) = w;
      }
  }
#undef SLOADE
#undef SLOADO
#undef SWRITE
#undef SWAIT
#undef RESC
}

DI void phase_final_norm(const Params& p) {
  const u16* XBf = (const u16*)(p.ws + OFF_Q); const float* RS2 = (const float*)(p.ws + OFF_RS2);
  const int tidk = otid(); const int lane = tidk & 63, wv = blockIdx.x * 8 + (tidk >> 6), nw = gridDim.x * 8;
  f32x4 g[4];
#pragma unroll
  for (int i = 0; i < 4; ++i) g[i] = *(const f32x4*)(p.final_norm_g + lane * 16 + i * 4);
  for (int t = wv; t < NTOK; t += nw) {
    const bf16x8 a = *(const bf16x8*)(XBf + (long)t * 1024 + lane * 16), b = *(const bf16x8*)(XBf + (long)t * 1024 + lane * 16 + 8);
    const float rs = rsqrtf(RS2[t] * (1.f / 1024.f) + EPS);
    float* row = p.out + (long)t * 1024 + lane * 16;
    *(f32x4*)(row + 0) = f32x4{bf2f((u16)a[0]) * rs * g[0][0], bf2f((u16)a[1]) * rs * g[0][1], bf2f((u16)a[2]) * rs * g[0][2], bf2f((u16)a[3]) * rs * g[0][3]};
    *(f32x4*)(row + 4) = f32x4{bf2f((u16)a[4]) * rs * g[1][0], bf2f((u16)a[5]) * rs * g[1][1], bf2f((u16)a[6]) * rs * g[1][2], bf2f((u16)a[7]) * rs * g[1][3]};
    *(f32x4*)(row + 8) = f32x4{bf2f((u16)b[0]) * rs * g[2][0], bf2f((u16)b[1]) * rs * g[2][1], bf2f((u16)b[2]) * rs * g[2][2], bf2f((u16)b[3]) * rs * g[2][3]};
    *(f32x4*)(row + 12) = f32x4{bf2f((u16)b[4]) * rs * g[3][0], bf2f((u16)b[5]) * rs * g[3][1], bf2f((u16)b[6]) * rs * g[3][2], bf2f((u16)b[7]) * rs * g[3][3]};
  }
}

constexpr int REP_P1 = 1, REP_P2 = 1, REP_ATTN = 1, REP_P3B = 1, REP_P4 = 1, REP_POOL = 1, REP_GW = 1, REP_GL = 1;
constexpr int cmax(int a, int b) { return a > b ? a : b; }
constexpr int SHM_TOTAL = cmax(cmax(SHM_GEMM, SHM_ATTN), cmax(cmax(SHM_GLA1, SHM_GLA2), SHM_POOL));

__global__ void __launch_bounds__(512, 1) hymba_megakernel(Params p) {
  __shared__ __attribute__((aligned(16))) char lds[SHM_TOTAL];
  cg::grid_group grid = cg::this_grid();
  const int nb = gridDim.x, bid = blockIdx.x;
  const int xcd = bid & 7, xloc = bid >> 3, xn = (nb - xcd + 7) >> 3;
  u16* Z = (u16*)(p.ws + OFF_Z); u16* Qg = (u16*)(p.ws + OFF_Q); u16* Kg = (u16*)(p.ws + OFF_K); u16* OL = (u16*)(p.ws + OFF_OL); u16* MIX = (u16*)(p.ws + OFF_MIX);
  if (blockIdx.x == 0 && threadIdx.x < 2) ((unsigned*)(p.ws + OFF_SC))[threadIdx.x * 64] = 0u;
  u16* XB = (u16*)(p.ws + OFF_Q);
  phase_weights(p, lds);
  {
    float* RS0 = (float*)(p.ws + OFF_RS0); float* RS1 = (float*)(p.ws + OFF_RS1);
    const int tk = otid(), lane = tk & 63;
    for (int tok = bid * 8 + (tk >> 6); tok < NTOK; tok += nb * 8) {
      const float* src = (tok < NP ? p.x_prompt + (long)tok * 1024 : p.x_sample + (long)(tok - NP) * 1024) + lane * 16;
      const f32x8 a = *(const f32x8*)src, b2 = *(const f32x8*)(src + 8);
      float ss = 0.f;
#pragma unroll
      for (int j = 0; j < 8; ++j) ss = fmaf(a[j], a[j], fmaf(b2[j], b2[j], ss));
      *(bf16x8*)(XB + (long)tok * 1024 + lane * 16) = cvt8(a); *(bf16x8*)(XB + (long)tok * 1024 + lane * 16 + 8) = cvt8(b2);
#pragma unroll
      for (int o = 1; o < 64; o <<= 1) ss += __shfl_xor(ss, o);
      if (lane == 0) { RS0[tok] = ss; RS1[tok] = 0.f; ((float*)(p.ws + OFF_RS2))[tok] = 0.f; }
    }
  }
  grid.sync();
#pragma unroll 1
  for (int l = 0; l < 2; ++l) {
    {
      pg8::Gemm g; g.A = XB; g.Bt = (const u16*)(p.ws + OFF_WIN + l * SZ_WIN); g.M = NTOK; g.N = ZLD; g.K = 1024;
      pg8::StaticOrder S; S.init(NTOK, ZLD, nb, bid);
      pg8::EpiZ E; E.Z = Z; E.VT = (u16*)(p.ws + OFF_VT); E.rowss = (const float*)(p.ws + (l == 0 ? OFF_RS0 : OFF_RS1));
      __syncthreads();
      pg8::gemm_phase<pg8::EpiZ, pg8::StaticOrder>((PG8_LAS unsigned char*)lds, g, S, E);
    }
    grid.sync();
    {
      Epi ep{}; ep.outb = Qg; ep.ldo = 768; ep.cs = (const float2*)(p.ws + OFF_CS);
      const u16* Wt = (const u16*)(p.ws + OFF_WQ + l * SZ_WQ);
      for (int rep = 0; rep < REP_P2; ++rep)
      for (int t = bid; t < 320 * 3; t += nb) { const int mb = t / 3, nt = t % 3; gemm_tile<EPI_Q, 4>(Z + ZQ, ZLD, Wt, 256, 256, (long)mb * 256, nt * 256, lds, ep); }
      __syncthreads(); glw_stage(p, l, lds); __syncthreads();
      for (int r2 = 0; r2 < REP_GL; ++r2) for (int task = bid * 8 + (otid() >> 6); task < 4 * NCHUNK; task += nb * 8) gla_local_wave(p, l, task, lds);
      phase_kbuild(p, l);
    }
    grid.sync();
    {
      unsigned* sc = (unsigned*)(p.ws + OFF_SC) + l * 64;
      phase_gla_scan(p);
      asm volatile("s_waitcnt vmcnt(0)" ::: "memory");
      __syncthreads();
      if (threadIdx.x == 0) { __builtin_amdgcn_fence(__ATOMIC_RELEASE, "agent"); asm volatile("s_waitcnt vmcnt(0)" ::: "memory");
        (void)__hip_atomic_fetch_add(sc, 1u, __ATOMIC_RELAXED, __HIP_MEMORY_SCOPE_AGENT); }
      for (int it = bid; it < 1280; it += nb) {
        long tokbase; int h, qb, seq;
        if (it < 1024) { tokbase = (long)(it >> 7) * 8192; h = (it >> 5) & 3; qb = it & 31; seq = 8192; }
        else { const int i2 = it - 1024; tokbase = NP + (long)(i2 >> 6) * 4096; h = (i2 >> 4) & 3; qb = i2 & 15; seq = 4096; }
        __syncthreads();
        attn_body(Qg + (tokbase + qb * 256) * 768 + h * 192, Kg + tokbase * 192, (const u16*)(p.ws + OFF_WUV + l * SZ_WUV) + h * 128 * 128,
                  Z + (tokbase + qb * 256) * ZLD + ZGM + h * 128, MIX + (tokbase + qb * 256) * 1024 + h * 128, seq, lds);
      }
      for (int t = bid; t < NCHUNK; t += nb) pool_chunk(p, l, t, lds);
      if (threadIdx.x == 0) {
        while (__hip_atomic_load(sc, __ATOMIC_RELAXED, __HIP_MEMORY_SCOPE_AGENT) < (unsigned)nb) __builtin_amdgcn_s_sleep(2);
        __builtin_amdgcn_fence(__ATOMIC_ACQUIRE, "agent"); asm volatile("s_waitcnt vmcnt(0)" ::: "memory");
      }
      __syncthreads();
      for (int task = bid * 8 + (otid() >> 6); task < 4 * NCHUNK; task += nb * 8) gla_out_wave(p, l, task);
    }
    grid.sync();
    {
      pg8::Gemm g; g.A = MIX; g.Bt = (const u16*)(p.ws + OFF_WOUT + l * SZ_WOUT); g.M = NTOK; g.N = 1024; g.K = 1024;
      pg8::StaticOrder S; S.init(NTOK, 1024, nb, bid);
      pg8::EpiRes E; E.out = (l == 0) ? p.out : nullptr; E.rp = (l == 0) ? p.x_prompt : p.out; E.rsm = (l == 0) ? p.x_sample - (long)NP * 1024 : p.out;
      E.xb = XB; E.rowss = (float*)(p.ws + (l == 0 ? OFF_RS1 : OFF_RS2));
      __syncthreads();
      pg8::gemm_phase<pg8::EpiRes, pg8::StaticOrder>((PG8_LAS unsigned char*)lds, g, S, E);
    }
    grid.sync();
  }
  phase_final_norm(p);
}

extern "C" void kernel_launch(void* const* d_in, const int* in_sizes, int n_in, void* d_out, int out_size, void* d_ws, size_t ws_size, hipStream_t stream) {
  static int grid_blocks = 0;
  if (!grid_blocks) {
    int dev = 0, cus = 0, per_cu = 0;
    hipGetDevice(&dev);
    hipDeviceGetAttribute(&cus, hipDeviceAttributeMultiprocessorCount, dev);
    hipOccupancyMaxActiveBlocksPerMultiprocessor(&per_cu, hymba_megakernel, 512, 0);
    if (per_cu < 1) per_cu = 1;
    if (per_cu > 1) per_cu = 1;
    grid_blocks = cus * per_cu;
  }
  if (n_in != 17 || ws_size < WS_END) { fprintf(stderr, "kernel_launch: bad args n_in %d ws %zu need %zu\n", n_in, ws_size, WS_END); return; }
  Params p{};
  p.x_prompt = (const float*)d_in[0]; p.x_sample = (const float*)d_in[1]; p.norm_g = (const float*)d_in[2]; p.w_in = (const float*)d_in[3];
  p.q_norm_g = (const float*)d_in[4]; p.w_uq = (const float*)d_in[5]; p.kv_norm_g = (const float*)d_in[6]; p.w_ukv = (const float*)d_in[7];
  p.w_pool = (const float*)d_in[8]; p.pool_scale = (const float*)d_in[9]; p.gk_up_fwd = (const float*)d_in[10]; p.gk_bias_fwd = (const float*)d_in[11];
  p.gk_up_bwd = (const float*)d_in[12]; p.gk_bias_bwd = (const float*)d_in[13]; p.gla_norm_g = (const float*)d_in[14]; p.w_out = (const float*)d_in[15];
  p.final_norm_g = (const float*)d_in[16]; p.out = (float*)d_out; p.ws = (char*)d_ws;
  void* args[] = {&p};
  hipError_t e = hipLaunchCooperativeKernel((void*)hymba_megakernel, dim3(grid_blocks), dim3(512), args, 0, stream);
  if (e != hipSuccess) fprintf(stderr, "cooperative launch failed: %s (grid %d)\n", hipGetErrorString(e), grid_blocks);
}
```

```cpp
#include <hip/hip_runtime.h>
#include <hip/hip_cooperative_groups.h>
#include <cstdio>
#include <cstdint>
namespace cg = cooperative_groups;

typedef unsigned short u16;
using bf16x8 = __attribute__((ext_vector_type(8))) short;
using s16x4  = __attribute__((ext_vector_type(4))) short;
using f32x16 = __attribute__((ext_vector_type(16))) float;
using f32x8  = __attribute__((ext_vector_type(8))) float;
using f32x4  = __attribute__((ext_vector_type(4))) float;
using u32x4  = __attribute__((ext_vector_type(4))) unsigned;
#define DI __device__ __forceinline__
#define SBAR() __builtin_amdgcn_sched_barrier(0)

constexpr int NTOK = 81920, NP = 65536;
constexpr int DM = 1024, ZLD = 2304, INC = 2272;
constexpr int ZQ = 0, ZKV = 256, ZKR = 384, ZGM = 448, ZUP = 960, ZGP = 1216, ZGQ = 1472, ZGK = 1600, ZGV = 1728, ZLF = 1984, ZLB = 2000, ZGG = 2016;
constexpr int NCHUNK = NTOK / 64;
constexpr float EPS = 1e-6f;
constexpr float MLA_SCALE = 0.07216878364870322f;

constexpr size_t SZ_WIN = (size_t)ZLD * 1024 * 2, SZ_WOUT = (size_t)1024 * 1024 * 2, SZ_WQ = (size_t)768 * 256 * 2, SZ_WUV = (size_t)512 * 128 * 2;
constexpr size_t OFF_WIN = 0;
constexpr size_t OFF_WOUT = OFF_WIN + 2 * SZ_WIN;
constexpr size_t OFF_WQ = OFF_WOUT + 2 * SZ_WOUT;
constexpr size_t OFF_WUV = OFF_WQ + 2 * SZ_WQ;
constexpr size_t OFF_CS = OFF_WUV + 2 * SZ_WUV;
constexpr size_t OFF_Z = OFF_CS + (size_t)8192 * 32 * 8;
constexpr size_t OFF_Q = OFF_Z + (size_t)NTOK * ZLD * 2;
constexpr size_t OFF_K = OFF_Q + (size_t)NTOK * 768 * 2;
constexpr size_t OFF_OL = OFF_K + (size_t)NTOK * 192 * 2;
constexpr size_t OFF_MIX = OFF_OL + (size_t)NTOK * 512 * 2;
constexpr size_t OFF_GC = OFF_MIX + (size_t)NTOK * 1024 * 2;
constexpr size_t OFF_LST = OFF_GC + (size_t)NTOK * 256 * 4;
constexpr size_t OFF_DK = OFF_LST + (size_t)2 * NCHUNK * 4 * 2048 * 4;
constexpr size_t OFF_VT = OFF_DK + (size_t)2 * NCHUNK * 4 * 32 * 4;
constexpr size_t OFF_RS0 = OFF_VT + (size_t)NCHUNK * 256 * 64 * 2;
constexpr size_t OFF_RS1 = OFF_RS0 + (size_t)NTOK * 4;
constexpr size_t OFF_RS2 = OFF_RS1 + (size_t)NTOK * 4;
constexpr size_t OFF_SC = OFF_RS2 + (size_t)NTOK * 4;
constexpr size_t WS_END = OFF_SC + 512;

struct Params {
  const float* x_prompt; const float* x_sample; const float* norm_g; const float* w_in; const float* q_norm_g; const float* w_uq;
  const float* kv_norm_g; const float* w_ukv; const float* w_pool; const float* pool_scale; const float* gk_up_fwd; const float* gk_bias_fwd;
  const float* gk_up_bwd; const float* gk_bias_bwd; const float* gla_norm_g; const float* w_out; const float* final_norm_g;
  float* out; char* ws;
};

DI int otid() { int t = threadIdx.x; asm volatile("" : "+v"(t)); return t; }
DI int crow(int r, int hi) { return (r & 3) + 8 * (r >> 2) + 4 * hi; }
typedef __bf16 bf16v2 __attribute__((ext_vector_type(2)));
typedef float f32v2 __attribute__((ext_vector_type(2)));
DI unsigned cvtpk(float lo, float hi) { f32v2 f = {lo, hi}; return __builtin_bit_cast(unsigned, __builtin_convertvector(f, bf16v2)); }
DI unsigned cvtpkv(float lo, float hi) { unsigned r; asm volatile("v_cvt_pk_bf16_f32 %0, %1, %2" : "=v"(r) : "v"(lo), "v"(hi)); return r; }
DI float bf2f(u16 v) { return __uint_as_float(((unsigned)v) << 16); }
DI u16 f2bf(float x) { return (u16)(cvtpk(x, 0.f) & 0xffffu); }
DI bf16x8 cvt8(f32x8 x) { u32x4 w = {cvtpk(x[0], x[1]), cvtpk(x[2], x[3]), cvtpk(x[4], x[5]), cvtpk(x[6], x[7])}; return __builtin_bit_cast(bf16x8, w); }
DI float silu(float x) { return x / (1.f + __expf(-x)); }
DI float logsig(float x) { return fminf(x, 0.f) - log1pf(__expf(-fabsf(x))); }
#define MFMA32(a, b, c) __builtin_amdgcn_mfma_f32_32x32x16_bf16((a), (b), (c), 0, 0, 0)
DI bf16x8 pack8(const f32x16& x, int s) {
  u32x4 w = {cvtpk(x[8 * s + 0], x[8 * s + 1]), cvtpk(x[8 * s + 2], x[8 * s + 3]), cvtpk(x[8 * s + 4], x[8 * s + 5]), cvtpk(x[8 * s + 6], x[8 * s + 7])};
  return __builtin_bit_cast(bf16x8, w);
}
DI int tok_pos(int g) { return g < NP ? (g & 8191) : ((g - NP) & 4095); }

constexpr int G_ASZ = 256 * 128, G_BSZ = 128 * 128, G_STAGE = G_ASZ + G_BSZ;
constexpr int SHM_GEMM = 2 * (G_ASZ + 256 * 128) + 1024;
DI int gswz(int row, int chunk) { return row * 128 + ((chunk ^ ((row >> 1) & 7)) << 4); }
enum { EPI_Z = 0, EPI_Q = 1, EPI_GATE = 2, EPI_RES = 3 };
struct Epi {
  u16* outb; long ldo;
  float* outf; const float* resid;
  const u16* gate;
  const float2* cs;
  u16* vt;
};

template <int EPI, int MT>
DI void gemm_tile(const u16* __restrict__ Av, long lda, const u16* __restrict__ Bt, long ldb, int K, long m0, int n0, char* lds, const Epi& ep) {
  constexpr bool RS = (EPI == EPI_Z || EPI == EPI_Q);
  constexpr int BN = MT == 2 ? 128 : 256, NB = BN / 64, BSZ = BN * 128, STAGE = G_ASZ + BSZ;
  const int tid = otid(), wid = tid >> 6, lane = tid & 63, r32 = lane & 31, hi = lane >> 5;
  const int wm = MT == 2 ? (wid >> 1) : (wid >> 2), wn = MT == 2 ? (wid & 1) : (wid & 3);
  const int srow = tid >> 3, sch = tid & 7;
  float* rs_l = (float*)(lds + 2 * STAGE);
  f32x16 acc[MT][2];
#pragma unroll
  for (int a = 0; a < MT; ++a)
#pragma unroll
    for (int b = 0; b < 2; ++b)
#pragma unroll
      for (int r = 0; r < 16; ++r) acc[a][b][r] = 0.f;
  float ss0 = 0.f, ss1 = 0.f, ss2 = 0.f, ss3 = 0.f;
  const int KT = K >> 6;
  bf16x8 a0_0, a0_1, a0_2, a0_3, b0_0, b0_1, b0_2, b0_3;
  bf16x8 a1_0, a1_1, a1_2, a1_3, b1_0, b1_1, b1_2, b1_3;
  const u16* Ab = Av + (m0 + srow) * lda + sch * 8;
  const u16* Bp = Bt + (long)(n0 + srow) * ldb + sch * 8;
  const int so0 = gswz(srow, sch), so1 = gswz(srow + 64, sch), so2 = gswz(srow + 128, sch), so3 = gswz(srow + 192, sch);
#define GLOAD(S, kt) do { a##S##_0 = *(const bf16x8*)(Ab + (kt) * 64); a##S##_1 = *(const bf16x8*)(Ab + 64 * lda + (kt) * 64);                         \
    a##S##_2 = *(const bf16x8*)(Ab + 128 * lda + (kt) * 64); a##S##_3 = *(const bf16x8*)(Ab + 192 * lda + (kt) * 64);                                    \
    b##S##_0 = *(const bf16x8*)(Bp + (kt) * 64); b##S##_1 = *(const bf16x8*)(Bp + 64 * ldb + (kt) * 64);                                                 \
    if constexpr (NB == 4) { b##S##_2 = *(const bf16x8*)(Bp + 128 * ldb + (kt) * 64); b##S##_3 = *(const bf16x8*)(Bp + 192 * ldb + (kt) * 64); } } while (0)
#define SSQB(v, s) do { _Pragma("unroll") for (int j_ = 0; j_ < 8; ++j_) { float f_ = bf2f((u16)v[j_]); s = fmaf(f_, f_, s); } } while (0)
#define GSTORE(S, buf, real) do { char* base_ = lds + (buf) * STAGE;                                                                                      \
    if constexpr (RS) if (real) { SSQB(a##S##_0, ss0); SSQB(a##S##_1, ss1); SSQB(a##S##_2, ss2); SSQB(a##S##_3, ss3); }                                  \
    *(bf16x8*)(base_ + so0) = a##S##_0; *(bf16x8*)(base_ + so1) = a##S##_1; *(bf16x8*)(base_ + so2) = a##S##_2; *(bf16x8*)(base_ + so3) = a##S##_3;      \
    *(bf16x8*)(base_ + G_ASZ + so0) = b##S##_0; *(bf16x8*)(base_ + G_ASZ + so1) = b##S##_1;                                                              \
    if constexpr (NB == 4) { *(bf16x8*)(base_ + G_ASZ + so2) = b##S##_2; *(bf16x8*)(base_ + G_ASZ + so3) = b##S##_3; } } while (0)
#define GCOMP(buf) do { const char* Ab_l = lds + (buf) * STAGE; const char* Bb_l = Ab_l + G_ASZ;                                                          \
    _Pragma("unroll") for (int s = 0; s < 4; ++s) { const int ch = s * 2 + hi;                                                                           \
      bf16x8 fa[MT], fb0, fb1;                                                                                                                            \
      _Pragma("unroll") for (int mt = 0; mt < MT; ++mt) fa[mt] = *(const bf16x8*)(Ab_l + gswz(wm * (MT * 32) + mt * 32 + r32, ch));                       \
      fb0 = *(const bf16x8*)(Bb_l + gswz(wn * 64 + r32, ch)); fb1 = *(const bf16x8*)(Bb_l + gswz(wn * 64 + 32 + r32, ch));                               \
      _Pragma("unroll") for (int mt = 0; mt < MT; ++mt) {                                                                                                 \
        acc[mt][0] = __builtin_amdgcn_mfma_f32_32x32x16_bf16(fb0, fa[mt], acc[mt][0], 0, 0, 0);                    \
        acc[mt][1] = __builtin_amdgcn_mfma_f32_32x32x16_bf16(fb1, fa[mt], acc[mt][1], 0, 0, 0); }                                                          \
      if constexpr (MT == 4) SBAR(); } } while (0)
  asm volatile("s_waitcnt vmcnt(0)" ::: "memory");
  __syncthreads();
  if constexpr (MT == 2) {
    GLOAD(0, 0); SBAR(); GLOAD(1, 1); SBAR();
    GSTORE(0, 0, true); SBAR(); GLOAD(0, min(2, KT - 1)); SBAR();
    __syncthreads();
#pragma unroll 1
    for (int kt = 0; kt < KT; kt += 2) {
      GCOMP(0);
      GSTORE(1, 1, true);
      GLOAD(1, min(kt + 3, KT - 1));
      __syncthreads();
      GCOMP(1);
      GSTORE(0, 0, kt + 2 < KT);
      GLOAD(0, min(kt + 4, KT - 1));
      __syncthreads();
    }
  } else {
    GLOAD(0, 0); GSTORE(0, 0, true);
    __syncthreads();
#pragma unroll 1
    for (int kt = 0; kt < KT; kt += 2) {
      GLOAD(0, kt + 1); SBAR();
      GCOMP(0);
      GSTORE(0, 1, true);
      __syncthreads();
      GLOAD(0, min(kt + 2, KT - 1)); SBAR();
      GCOMP(1);
      GSTORE(0, 0, kt + 2 < KT);
      __syncthreads();
    }
  }
#undef GLOAD
#undef GSTORE
#undef GCOMP
#undef SSQB
  if constexpr (RS) {
    float s4[4] = {ss0, ss1, ss2, ss3};
#pragma unroll
    for (int i = 0; i < 4; ++i) {
      float s = s4[i];
      s += __shfl_xor(s, 1); s += __shfl_xor(s, 2); s += __shfl_xor(s, 4);
      if (sch == 0) rs_l[srow + 64 * i] = rsqrtf(s / (float)K + EPS);
    }
    __syncthreads();
  }
  const bool rope = (EPI == EPI_Q) && (((n0 + wn * 64) % 192) == 128);
  const bool isV = (EPI == EPI_Z) && (n0 + wn * 64 >= ZGV) && (n0 + wn * 64 < ZGV + 256);
#pragma unroll
  for (int mt = 0; mt < MT; ++mt) {
    const int rl = wm * (MT * 32) + mt * 32 + r32;
    const long g = m0 + rl;
    float rs = 1.f;
    if constexpr (RS) rs = rs_l[rl];
#pragma unroll
    for (int q = 0; q < 4; ++q) {
      const int cq = n0 + wn * 64 + 8 * q + 4 * hi;
      float v0[4], v1[4];
#pragma unroll
      for (int j = 0; j < 4; ++j) { v0[j] = acc[mt][0][4 * q + j] * rs; v1[j] = acc[mt][1][4 * q + j] * rs; }
      if constexpr (EPI == EPI_Z) {
        uint2 w0, w1; w0.x = cvtpk(v0[0], v0[1]); w0.y = cvtpk(v0[2], v0[3]); w1.x = cvtpk(v1[0], v1[1]); w1.y = cvtpk(v1[2], v1[3]);
        *(uint2*)(ep.outb + g * ep.ldo + cq) = w0; *(uint2*)(ep.outb + g * ep.ldo + cq + 32) = w1;
        if (isV) {
          u16* vp = ep.vt + ((g >> 6) * 256 + (cq - ZGV)) * 64 + (g & 63);
          vp[0 * 64] = (u16)(w0.x & 0xffff); vp[1 * 64] = (u16)(w0.x >> 16); vp[2 * 64] = (u16)(w0.y & 0xffff); vp[3 * 64] = (u16)(w0.y >> 16);
          vp[32 * 64] = (u16)(w1.x & 0xffff); vp[33 * 64] = (u16)(w1.x >> 16); vp[34 * 64] = (u16)(w1.y & 0xffff); vp[35 * 64] = (u16)(w1.y >> 16);
        }
      } else if constexpr (EPI == EPI_Q) {
        if (rope) {
          const f32x8 cs = *(const f32x8*)((const float*)ep.cs + ((long)tok_pos((int)g) * 32 + 8 * q + 4 * hi) * 2);
#pragma unroll
          for (int j = 0; j < 4; ++j) { const float x1 = v0[j], x2 = v1[j]; v0[j] = x1 * cs[2 * j] - x2 * cs[2 * j + 1]; v1[j] = x2 * cs[2 * j] + x1 * cs[2 * j + 1]; }
        }
        uint2 w0, w1; w0.x = cvtpk(v0[0], v0[1]); w0.y = cvtpk(v0[2], v0[3]); w1.x = cvtpk(v1[0], v1[1]); w1.y = cvtpk(v1[2], v1[3]);
        *(uint2*)(ep.outb + g * ep.ldo + cq) = w0; *(uint2*)(ep.outb + g * ep.ldo + cq + 32) = w1;
      } else if constexpr (EPI == EPI_GATE) {
        const uint2 g0 = *(const uint2*)(ep.gate + g * ZLD + cq), g1 = *(const uint2*)(ep.gate + g * ZLD + cq + 32);
        v0[0] *= silu(__uint_as_float(g0.x << 16)); v0[1] *= silu(__uint_as_float(g0.x & 0xffff0000u)); v0[2] *= silu(__uint_as_float(g0.y << 16)); v0[3] *= silu(__uint_as_float(g0.y & 0xffff0000u));
        v1[0] *= silu(__uint_as_float(g1.x << 16)); v1[1] *= silu(__uint_as_float(g1.x & 0xffff0000u)); v1[2] *= silu(__uint_as_float(g1.y << 16)); v1[3] *= silu(__uint_as_float(g1.y & 0xffff0000u));
        uint2 w0, w1; w0.x = cvtpk(v0[0], v0[1]); w0.y = cvtpk(v0[2], v0[3]); w1.x = cvtpk(v1[0], v1[1]); w1.y = cvtpk(v1[2], v1[3]);
        *(uint2*)(ep.outb + g * ep.ldo + cq) = w0; *(uint2*)(ep.outb + g * ep.ldo + cq + 32) = w1;
      } else {
        const f32x4 r0 = *(const f32x4*)(ep.resid + g * 1024 + cq), r1 = *(const f32x4*)(ep.resid + g * 1024 + cq + 32);
#pragma unroll
        for (int j = 0; j < 4; ++j) { v0[j] += r0[j]; v1[j] += r1[j]; }
        *(f32x4*)(ep.outf + g * 1024 + cq) = f32x4{v0[0], v0[1], v0[2], v0[3]}; *(f32x4*)(ep.outf + g * 1024 + cq + 32) = f32x4{v1[0], v1[1], v1[2], v1[3]};
        if (ep.outb) { uint2 w0, w1; w0.x = cvtpk(v0[0], v0[1]); w0.y = cvtpk(v0[2], v0[3]); w1.x = cvtpk(v1[0], v1[1]); w1.y = cvtpk(v1[2], v1[3]);
          *(uint2*)(ep.outb + g * 1024 + cq) = w0; *(uint2*)(ep.outb + g * 1024 + cq + 32) = w1; }
      }
    }
    SBAR();
  }
}

namespace pg8 {
#define PG8_LAS __attribute__((address_space(3)))
typedef unsigned short bf16_t;
constexpr int BM = 256, BK = 64, HALF = 128, HTB = HALF * BK * 2, STAGE_BYTES = 8 * HTB, NXCD = 8, WGM = 8;
DI int lds_byte(int r, int c) { const int st = (r >> 4) * 2 + (c >> 5), rr = r & 15, cc = c & 31, ob = rr * 64 + cc * 2; return st * 1024 + (ob ^ (((ob >> 9) & 1) << 5)); }
DI void stage_rc(int b, int& R, int& C) { const int st = b / 1024, sb = b % 1024, swz = sb ^ (((sb >> 9) & 1) << 5); R = (st >> 1) * 16 + swz / 64; C = (st & 1) * 32 + (swz % 64) / 2; }
DI int perm32(int rho) { const int n = rho >> 4, i = rho & 15; return 8 * (i >> 2) + 4 * n + (i & 3); }
struct Unit { int pm, pn; };
struct Gemm { const bf16_t* A; const bf16_t* Bt; int M, N, K; };
struct StaticOrder {
    int nM, nN, nwg, G, c;
    DI void init(int M, int N, int G_, int c_) { nM = M / BM; nN = N / BM; nwg = nM * nN; G = G_; c = c_; }
    DI bool next(int i, Unit& u) const {
        const long L = (long)i * G + c; if (L >= nwg) return false;
        int wgid = (int)L; { const int q = nwg / NXCD, r = nwg % NXCD, xcd = wgid % NXCD, off = wgid / NXCD; wgid = (xcd < r ? xcd * (q + 1) : r * (q + 1) + (xcd - r) * q) + off; }
        const int nig = WGM * nN, gid = wgid / nig, fm = gid * WGM, gsz = (nM - fm) < WGM ? (nM - fm) : WGM;
        u.pm = fm + ((wgid % nig) % gsz); u.pn = (wgid % nig) / gsz; return true;
    }
    DI void a_ready(const Unit&) const {}
    DI void done(const Unit&) const {}
};
template <class Epi, class Sched>
__device__ __forceinline__ void gemm_phase(PG8_LAS unsigned char* lds, const Gemm g, const Sched& S, const Epi& E) {
    const int tid = otid(), wid = __builtin_amdgcn_readfirstlane(tid >> 6), lane = tid & 63, wr = wid >> 2, wc = wid & 3, fr = lane & 15, fq = lane >> 4;
    const int K = g.K, nt = K / BK;
    unsigned voffA[2], voffB[2];
#pragma unroll
    for (int i = 0; i < 2; ++i) { int R, C; stage_rc(tid * 16 + i * 8192, R, C); const int Rb = Epi::PERM ? ((R & ~31) + perm32(R & 31)) : R;
        voffA[i] = (unsigned)(R * K + C) * 2u; voffB[i] = (unsigned)(Rb * K + C) * 2u; }
    const size_t kstep = (size_t)(BK * 2);
    const size_t hstep = (size_t)HALF * K * 2;
    const size_t tstep = 2 * hstep;
    const unsigned ldsw = (unsigned)wid * 1024u;
    const int aoff = lds_byte(wr * 64 + fr, fq * 8), boff = lds_byte(wc * 32 + fr, fq * 8);
#define PG8_SA(b, h) (((b) * 2 + (h)) * HTB)
#define PG8_SB(b, h) ((4 + (b) * 2 + (h)) * HTB)
#define PG8_STAGE(bufoff, gbase, voff) do { _Pragma("unroll") for (int _i = 0; _i < 2; ++_i) \
        __builtin_amdgcn_global_load_lds((const unsigned*)((const char*)(gbase) + (voff)[_i]), (PG8_LAS unsigned*)(lds + (bufoff) + ldsw + _i * 8192), 16, 0, 0); } while (0)
#define PG8_LDA(dst, b, h) do { _Pragma("unroll") for (int m = 0; m < 4; ++m) _Pragma("unroll") for (int k = 0; k < 2; ++k) dst[m][k] = *(const PG8_LAS bf16x8*)(lds + PG8_SA(b, h) + aoff + m * 2048 + k * 1024); } while (0)
#define PG8_LDB(dst, b, h) do { _Pragma("unroll") for (int n = 0; n < 2; ++n) _Pragma("unroll") for (int k = 0; k < 2; ++k) dst[n][k] = *(const PG8_LAS bf16x8*)(lds + PG8_SB(b, h) + boff + n * 2048 + k * 1024); } while (0)
#define PG8_MMA(ai, bj, At, Bt) do { __builtin_amdgcn_s_setprio(1); _Pragma("unroll") for (int m = 0; m < 4; ++m) _Pragma("unroll") for (int n = 0; n < 2; ++n) _Pragma("unroll") for (int k = 0; k < 2; ++k) \
        acc[ai][bj][m][n] = __builtin_amdgcn_mfma_f32_16x16x32_bf16(Bt[n][k], At[m][k], acc[ai][bj][m][n], 0, 0, 0); __builtin_amdgcn_s_setprio(0); } while (0)
#define PG8_WAIT_V(n) asm volatile("s_waitcnt vmcnt(" #n ")" ::: "memory")
#define PG8_WAIT_L(n) asm volatile("s_waitcnt lgkmcnt(" #n ")" ::: "memory")
#define PG8_BAR __builtin_amdgcn_s_barrier()
#define PG8_SCHED __builtin_amdgcn_sched_barrier(0)
    Unit cur, nxt; int ui = 0;
    if (!S.next(0, cur)) return;
    f32x4 acc[2][2][4][2];
#pragma unroll
    for (int a = 0; a < 2; ++a)
#pragma unroll
        for (int b = 0; b < 2; ++b)
#pragma unroll
            for (int m = 0; m < 4; ++m)
#pragma unroll
                for (int n = 0; n < 2; ++n) acc[a][b][m][n] = (f32x4){0.f, 0.f, 0.f, 0.f};
    bf16x8 At[4][2], B0[2][2], B1[2][2];
    const char* cA = (const char*)g.A + (size_t)cur.pm * tstep; const char* cB = (const char*)g.Bt + (size_t)cur.pn * tstep;
    S.a_ready(cur);
    PG8_STAGE(PG8_SB(0, 0), cB, voffB); PG8_STAGE(PG8_SA(0, 0), cA, voffA); PG8_STAGE(PG8_SB(0, 1), cB + hstep, voffB); PG8_STAGE(PG8_SA(0, 1), cA + hstep, voffA);
    if (wr == 1) PG8_BAR;
    PG8_WAIT_V(4); PG8_BAR;
    PG8_STAGE(PG8_SB(1, 0), cB + kstep, voffB); PG8_STAGE(PG8_SA(1, 0), cA + kstep, voffA); PG8_STAGE(PG8_SB(1, 1), cB + hstep + kstep, voffB);
    PG8_WAIT_V(6); PG8_BAR;
    for (;;) {
        const bool has_next = S.next(ui + 1, nxt);
        const char* nA = has_next ? (const char*)g.A + (size_t)nxt.pm * tstep : cA; const char* nB = has_next ? (const char*)g.Bt + (size_t)nxt.pn * tstep : cB;
        for (int t = 0; t < nt; t += 2) {
            const bool last = (t == nt - 2);
            const char* a1 = cA + (size_t)(t + 1) * kstep;
            const char* a2 = last ? nA : cA + (size_t)(t + 2) * kstep; const char* b2 = last ? nB : cB + (size_t)(t + 2) * kstep;
            const char* a3 = a2 + kstep; const char* b3 = b2 + kstep;
            if (last && has_next) S.a_ready(nxt);
            PG8_LDB(B0, 0, 0); PG8_SCHED; PG8_LDA(At, 0, 0); PG8_STAGE(PG8_SA(1, 1), a1 + hstep, voffA);
            PG8_WAIT_L(8); PG8_BAR; PG8_WAIT_L(0); PG8_MMA(0, 0, At, B0); PG8_BAR; PG8_SCHED;
            PG8_LDB(B1, 0, 1); PG8_STAGE(PG8_SB(0, 0), b2, voffB);
            PG8_BAR; PG8_WAIT_L(0); PG8_MMA(0, 1, At, B1); PG8_BAR;
            PG8_LDA(At, 0, 1); PG8_STAGE(PG8_SA(0, 0), a2, voffA);
            PG8_BAR; PG8_WAIT_L(0); PG8_MMA(1, 0, At, B0); PG8_BAR; PG8_SCHED;
            PG8_STAGE(PG8_SB(0, 1), b2 + hstep, voffB);
            PG8_WAIT_V(6); PG8_BAR; PG8_MMA(1, 1, At, B1); PG8_BAR;
            PG8_LDB(B0, 1, 0); PG8_SCHED; PG8_LDA(At, 1, 0); PG8_STAGE(PG8_SA(0, 1), a2 + hstep, voffA);
            PG8_WAIT_L(8); PG8_BAR; PG8_WAIT_L(0); PG8_MMA(0, 0, At, B0); PG8_BAR; PG8_SCHED;
            PG8_LDB(B1, 1, 1); PG8_STAGE(PG8_SB(1, 0), b3, voffB);
            PG8_BAR; PG8_WAIT_L(0); PG8_MMA(0, 1, At, B1); PG8_BAR;
            PG8_LDA(At, 1, 1); PG8_STAGE(PG8_SA(1, 0), a3, voffA);
            PG8_BAR; PG8_WAIT_L(0); PG8_MMA(1, 0, At, B0); PG8_BAR; PG8_SCHED;
            PG8_STAGE(PG8_SB(1, 1), b3 + hstep, voffB);
            PG8_WAIT_V(6); PG8_BAR; PG8_MMA(1, 1, At, B1); PG8_BAR;
        }
        if constexpr (!Epi::AFTER_DRAIN) { E(acc, cur, wr, wc, fr, fq); S.done(cur); }
        if (!has_next) break;
#pragma unroll
        for (int a = 0; a < 2; ++a)
#pragma unroll
            for (int b = 0; b < 2; ++b)
#pragma unroll
                for (int m = 0; m < 4; ++m)
#pragma unroll
                    for (int n = 0; n < 2; ++n) acc[a][b][m][n] = (f32x4){0.f, 0.f, 0.f, 0.f};
        cur = nxt; cA = nA; cB = nB; ++ui;
    }
    PG8_WAIT_V(0);
    if (wr == 0) PG8_BAR;
    PG8_BAR;
    if constexpr (Epi::AFTER_DRAIN) { E.fused(acc, cur, wr, wc, fr, fq, lds, wid, lane); S.done(cur); }
#undef PG8_SA
#undef PG8_SB
#undef PG8_STAGE
#undef PG8_LDA
#undef PG8_LDB
#undef PG8_MMA
#undef PG8_WAIT_V
#undef PG8_WAIT_L
#undef PG8_BAR
#undef PG8_SCHED
}

struct EpiZ {
    static constexpr bool PERM = true, AFTER_DRAIN = false;
    u16* Z; u16* VT; const float* rowss;
    DI void operator()(const f32x4 (&acc)[2][2][4][2], const Unit& u, int wr, int wc, int fr, int fq) const {
#pragma unroll
        for (int ai = 0; ai < 2; ++ai)
#pragma unroll
            for (int m = 0; m < 4; ++m) {
                const long row = (long)u.pm * 256 + 128 * ai + 64 * wr + 16 * m + fr;
                const float rs = rsqrtf(rowss[row] * (1.f / 1024.f) + EPS);
#pragma unroll
                for (int bj = 0; bj < 2; ++bj) {
                    const int c0 = u.pn * 256 + 128 * bj + 32 * wc + 8 * fq;
                    const f32x4 x = acc[ai][bj][m][0], y = acc[ai][bj][m][1];
                    u32x4 w = {cvtpk(x[0] * rs, x[1] * rs), cvtpk(x[2] * rs, x[3] * rs), cvtpk(y[0] * rs, y[1] * rs), cvtpk(y[2] * rs, y[3] * rs)};
                    *(u32x4*)(Z + row * ZLD + c0) = w;
                    if (c0 >= ZGV && c0 < ZGV + 256) {
                        u16* vp = VT + ((row >> 6) * 256 + (c0 - ZGV)) * 64 + (row & 63);
#pragma unroll
                        for (int j = 0; j < 4; ++j) { vp[(2 * j) * 64] = (u16)(w[j] & 0xffffu); vp[(2 * j + 1) * 64] = (u16)(w[j] >> 16); }
                    }
                }
            }
    }
};
struct EpiRes {
    static constexpr bool PERM = true, AFTER_DRAIN = false;
    float* out; const float* rp; const float* rsm; u16* xb; float* rowss;
    DI void operator()(const f32x4 (&acc)[2][2][4][2], const Unit& u, int wr, int wc, int fr, int fq) const {
#pragma unroll
        for (int ai = 0; ai < 2; ++ai)
#pragma unroll
            for (int m = 0; m < 4; ++m) {
                const long row = (long)u.pm * 256 + 128 * ai + 64 * wr + 16 * m + fr;
                const float* res = (row < NP ? rp : rsm) + row * 1024;
                float ssq = 0.f;
#pragma unroll
                for (int bj = 0; bj < 2; ++bj) {
                    const int c0 = u.pn * 256 + 128 * bj + 32 * wc + 8 * fq;
                    const f32x4 r0 = *(const f32x4*)(res + c0), r1 = *(const f32x4*)(res + c0 + 4);
                    f32x4 x = acc[ai][bj][m][0], y = acc[ai][bj][m][1];
#pragma unroll
                    for (int j = 0; j < 4; ++j) { x[j] += r0[j]; y[j] += r1[j]; ssq = fmaf(x[j], x[j], fmaf(y[j], y[j], ssq)); }
                    if (out) { *(f32x4*)(out + row * 1024 + c0) = x; *(f32x4*)(out + row * 1024 + c0 + 4) = y; }
                    if (xb) { u32x4 w = {cvtpk(x[0], x[1]), cvtpk(x[2], x[3]), cvtpk(y[0], y[1]), cvtpk(y[2], y[3])}; *(u32x4*)(xb + row * 1024 + c0) = w; }
                }
                if (rowss) { ssq += __shfl_xor(ssq, 16); ssq += __shfl_xor(ssq, 32); if (fq == 0) atomicAdd(rowss + row, ssq); }
            }
    }
};
}

DI void transpose_tile(const float* __restrict__ src, int ldsrc, int coloff, int N, int K, const float* __restrict__ gsc, u16* __restrict__ dst,
                       int kt, int nt, char* lds) {
  float* T = (float*)lds;
  const int tid = otid();
#pragma unroll
  for (int i = 0; i < 2; ++i) {
    const int kk = (tid >> 4) + 32 * i, n4 = (tid & 15) * 4, k = kt * 64 + kk, n = nt * 64 + n4;
    f32x4 v = {0.f, 0.f, 0.f, 0.f};
    if (n < N) v = *(const f32x4*)(src + (long)k * ldsrc + coloff + n);
    const float gs = gsc ? gsc[k] : 1.f;
    T[kk * 65 + n4 + 0] = v[0] * gs; T[kk * 65 + n4 + 1] = v[1] * gs; T[kk * 65 + n4 + 2] = v[2] * gs; T[kk * 65 + n4 + 3] = v[3] * gs;
  }
  __syncthreads();
  {
    const int n = tid >> 3, k8 = (tid & 7) * 8;
    u32x4 w;
    w[0] = cvtpk(T[(k8 + 0) * 65 + n], T[(k8 + 1) * 65 + n]); w[1] = cvtpk(T[(k8 + 2) * 65 + n], T[(k8 + 3) * 65 + n]);
    w[2] = cvtpk(T[(k8 + 4) * 65 + n], T[(k8 + 5) * 65 + n]); w[3] = cvtpk(T[(k8 + 6) * 65 + n], T[(k8 + 7) * 65 + n]);
    *(u32x4*)(dst + (long)(nt * 64 + n) * K + kt * 64 + k8) = w;
  }
  __syncthreads();
}

DI void phase_weights(const Params& p, char* lds) {
  const int nb = gridDim.x, bid = blockIdx.x;
  for (int it = bid; it < 2 * 864; it += nb) {
    const int l = it / 864; int t = it % 864;
    if (t < 576) { transpose_tile(p.w_in + (long)l * 1024 * INC, INC, 0, INC, 1024, p.norm_g + l * 1024, (u16*)(p.ws + OFF_WIN + l * SZ_WIN), t / 36, t % 36, lds); }
    else if ((t -= 576) < 256) { transpose_tile(p.w_out + (long)l * 1024 * 1024, 1024, 0, 1024, 1024, nullptr, (u16*)(p.ws + OFF_WOUT + l * SZ_WOUT), t >> 4, t & 15, lds); }
    else if ((t -= 256) < 16) { const int h = t >> 2; transpose_tile(p.w_ukv + (long)l * 128 * 1024, 1024, h * 256 + 128, 128, 128, nullptr,
                                                                     (u16*)(p.ws + OFF_WUV + l * SZ_WUV) + h * 128 * 128, (t >> 1) & 1, t & 1, lds); }
    else { t -= 16; const int h = t >> 2; transpose_tile(p.w_uq + (long)l * 256 * 768, 768, h * 192 + 128, 64, 256, p.q_norm_g + l * 256,
                                                         (u16*)(p.ws + OFF_WQ + l * SZ_WQ) + (h * 192 + 128) * 256, t & 3, 0, lds); }
  }
  const int nthr = nb * 512;
  for (int idx = bid * 512 + otid(); idx < 2 * 4 * 128 * 256; idx += nthr) {
    const int k = idx & 255, c = (idx >> 8) & 127, h = (idx >> 15) & 3, l = (int)(idx >> 17);
    const float* a = p.w_uq + (long)l * 256 * 768 + k * 768 + h * 192;
    const float* b = p.w_ukv + (long)l * 128 * 1024 + c * 1024 + h * 256;
    float s = 0.f;
    for (int e = 0; e < 128; e += 4) { const f32x4 x = *(const f32x4*)(a + e), y = *(const f32x4*)(b + e); s += x[0] * y[0] + x[1] * y[1] + x[2] * y[2] + x[3] * y[3]; }
    ((u16*)(p.ws + OFF_WQ + l * SZ_WQ))[(h * 192 + c) * 256 + k] = f2bf(s * p.q_norm_g[l * 256 + k]);
  }
  for (int idx = bid * 512 + otid(); idx < 8192 * 32; idx += nthr) {
    const int pos = (int)(idx >> 5), i = (int)(idx & 31);
    const float invf = exp2f(-(float)i * 0.41524101186092029f);
    const float ang = (float)pos * invf;
    const double x = (double)ang;
    const double kq = rint(x * 0.15915494309189535);
    const double r = fma(-kq, 6.283185307179586, x);
    const double r2 = r * r;
    double sn = r, tm = r, cn = 1.0, tc = 1.0;
#pragma unroll
    for (int n = 1; n <= 14; ++n) { tm *= -r2 * (1.0 / (double)((2 * n) * (2 * n + 1))); sn += tm; tc *= -r2 * (1.0 / (double)((2 * n - 1) * (2 * n))); cn += tc; }
    ((float2*)(p.ws + OFF_CS))[idx] = make_float2((float)cn, (float)sn);
  }
}

DI void phase_kbuild(const Params& p, int l) {
  const u16* Z = (const u16*)(p.ws + OFF_Z); u16* Kb = (u16*)(p.ws + OFF_K); const float* cs = (const float*)(p.ws + OFF_CS);
  const int tidk = otid(); const int lane = tidk & 63, j = lane & 7, sub = lane >> 3;
  const int wv = blockIdx.x * 8 + (tidk >> 6), nw = gridDim.x * 8;
  float g[16];
#pragma unroll
  for (int i = 0; i < 16; ++i) g[i] = p.kv_norm_g[l * 128 + j * 16 + i];
  for (int t0 = wv * 8; t0 < NTOK; t0 += nw * 8) {
    const long t = t0 + sub;
    const u16* zr = Z + t * ZLD;
    const bf16x8 a = *(const bf16x8*)(zr + ZKV + j * 16), b = *(const bf16x8*)(zr + ZKV + j * 16 + 8);
    const s16x4 x1v = *(const s16x4*)(zr + ZKR + 4 * j), x2v = *(const s16x4*)(zr + ZKR + 32 + 4 * j);
    const f32x8 c = *(const f32x8*)(cs + ((long)tok_pos((int)t) * 32 + 4 * j) * 2);
    float v[16]; float s = 0.f;
#pragma unroll
    for (int i = 0; i < 8; ++i) { v[i] = bf2f((u16)a[i]); v[8 + i] = bf2f((u16)b[i]); }
#pragma unroll
    for (int i = 0; i < 16; ++i) s = fmaf(v[i], v[i], s);
    s += __shfl_xor(s, 1); s += __shfl_xor(s, 2); s += __shfl_xor(s, 4);
    const float rs = rsqrtf(s * (1.f / 128.f) + EPS);
    u32x4 w0, w1;
#pragma unroll
    for (int i = 0; i < 4; ++i) { w0[i] = cvtpk(v[2 * i] * rs * g[2 * i], v[2 * i + 1] * rs * g[2 * i + 1]); w1[i] = cvtpk(v[8 + 2 * i] * rs * g[8 + 2 * i], v[9 + 2 * i] * rs * g[9 + 2 * i]); }
    u16* kr = Kb + t * 192;
    *(u32x4*)(kr + j * 16) = w0; *(u32x4*)(kr + j * 16 + 8) = w1;
    float o1[4], o2[4];
#pragma unroll
    for (int i = 0; i < 4; ++i) { const float x1 = bf2f((u16)x1v[i]), x2 = bf2f((u16)x2v[i]); o1[i] = x1 * c[2 * i] - x2 * c[2 * i + 1]; o2[i] = x2 * c[2 * i] + x1 * c[2 * i + 1]; }
    uint2 r1, r2; r1.x = cvtpk(o1[0], o1[1]); r1.y = cvtpk(o1[2], o1[3]); r2.x = cvtpk(o2[0], o2[1]); r2.y = cvtpk(o2[2], o2[3]);
    *(uint2*)(kr + 128 + 4 * j) = r1; *(uint2*)(kr + 160 + 4 * j) = r2;
  }
}

constexpr int SHM_GLA1 = 65536 + 32768 + 8192 + 1024;
DI void gla_local_chunk(const Params& p, int l, int chunk, char* lds) {
  const u16* Z = (const u16*)(p.ws + OFF_Z);
  float* G = (float*)lds; u16* V16 = (u16*)(lds + 65536); float* LR = (float*)(lds + 65536 + 32768); float* E = (float*)(lds + 65536 + 32768 + 8192);
  const int tid = otid(); const long t0 = (long)chunk * 64;
  __syncthreads();
  for (int i = tid; i < 64 * 32; i += 512) { const int t = i >> 5, r = i & 31; LR[i] = bf2f(Z[(t0 + t) * ZLD + ZLF + r]); }
  for (int i = tid; i < 64 * 32; i += 512) { const int t = i >> 5, c8 = (i & 31) * 8; *(bf16x8*)(V16 + t * 256 + c8) = *(const bf16x8*)(Z + (t0 + t) * ZLD + ZGV + c8); }
  __syncthreads();
  {
    const int col = tid & 255, dir = col >> 7, hd = col & 127, th = tid >> 8;
    const float* up = (dir ? p.gk_up_bwd : p.gk_up_fwd) + l * 16 * 128 + hd;
    const float bias = (dir ? p.gk_bias_bwd : p.gk_bias_fwd)[l * 128 + hd];
    float u[16];
#pragma unroll
    for (int r = 0; r < 16; ++r) u[r] = up[r * 128];
#pragma unroll 4
    for (int ii = 0; ii < 32; ++ii) {
      const int t = th * 32 + ii; float zz = bias;
#pragma unroll
      for (int r = 0; r < 16; ++r) zz = fmaf(LR[t * 32 + dir * 16 + r], u[r], zz);
      G[t * 256 + col] = logsig(zz) * (1.f / 16.f);
    }
  }
  __syncthreads();
  if (tid < 256) {
    float* GC = (float*)(p.ws + OFF_GC);
    float gv[64];
#pragma unroll
    for (int t = 0; t < 64; ++t) gv[t] = G[t * 256 + tid];
    float s = 0.f;
    if (tid < 128) {
#pragma unroll
      for (int t = 0; t < 64; ++t) { s += gv[t]; gv[t] = s; }
    } else {
#pragma unroll
      for (int t = 63; t >= 0; --t) { s += gv[t]; gv[t] = s; }
    }
#pragma unroll
    for (int t = 0; t < 64; ++t) { G[t * 256 + tid] = gv[t]; GC[(t0 + t) * 256 + tid] = gv[t]; }
    E[tid] = s;
    const int dir = tid >> 7, hd = tid & 127;
    ((float*)(p.ws + OFF_DK))[((long)dir * NCHUNK + chunk) * 128 + hd] = __expf(s);
  }
  __syncthreads();
#pragma unroll 8
  for (int i = tid; i < 64 * 256; i += 512) { const int t = i >> 8, col = i & 255, hd = col & 127;
    const float k = bf2f(Z[(t0 + t) * ZLD + ZGK + hd]); G[i] = k * __expf(E[col] - G[i]); }
  __syncthreads();
  {
    const int combo = tid >> 6, dir = combo >> 2, h = combo & 3, lane = tid & 63, d0 = (lane >> 3) * 4, e0 = (lane & 7) * 8;
    float acc[4][8];
#pragma unroll
    for (int a = 0; a < 4; ++a)
#pragma unroll
      for (int b = 0; b < 8; ++b) acc[a][b] = 0.f;
#pragma unroll 4
    for (int j = 0; j < 64; ++j) {
      const f32x4 kq = *(const f32x4*)(G + j * 256 + dir * 128 + h * 32 + d0);
      const bf16x8 vv = *(const bf16x8*)(V16 + j * 256 + h * 64 + e0);
#pragma unroll
      for (int b = 0; b < 8; ++b) { const float vf = bf2f((u16)vv[b]);
#pragma unroll
        for (int a = 0; a < 4; ++a) acc[a][b] = fmaf(kq[a], vf, acc[a][b]); }
    }
    float* L = (float*)(p.ws + OFF_LST) + (((long)dir * NCHUNK + chunk) * 4 + h) * 2048;
#pragma unroll
    for (int b = 0; b < 8; ++b) *(f32x4*)(L + (e0 + b) * 32 + d0) = f32x4{acc[0][b], acc[1][b], acc[2][b], acc[3][b]};
  }
}

constexpr int GLW_UPT = 0, GLW_BIAS = 16384, GLW_KT = 17408, GLW_KT_SZ = 9216, SHM_GLW = GLW_KT + 8 * GLW_KT_SZ;
DI void glw_stage(const Params& p, int l, char* lds) {
  float* UPT = (float*)(lds + GLW_UPT); float* BI = (float*)(lds + GLW_BIAS);
  const int tid = otid();
  for (int i = tid; i < 2 * 16 * 128; i += 512) { const int dir = i >> 11, r = (i >> 7) & 15, hd = i & 127;
    UPT[(dir * 128 + hd) * 16 + r] = (dir ? p.gk_up_bwd : p.gk_up_fwd)[l * 2048 + r * 128 + hd]; }
  if (tid < 256) BI[tid] = (tid < 128 ? p.gk_bias_fwd : p.gk_bias_bwd)[l * 128 + (tid & 127)];
}
DI void gla_local_wave(const Params& p, int l, int task, char* lds) {
  const u16* Z = (const u16*)(p.ws + OFF_Z); const u16* VT = (const u16*)(p.ws + OFF_VT);
  const float* UPT = (const float*)(lds + GLW_UPT); const float* BI = (const float*)(lds + GLW_BIAS);
  const int chunk = task >> 2, h = task & 3; const long t0 = (long)chunk * 64;
  const int tid = otid(), wid = tid >> 6, lane = tid & 63, r32 = lane & 31, hi = lane >> 5;
  char* KT = lds + GLW_KT + wid * GLW_KT_SZ;
  const long tok = t0 + lane;
  float lr[32], kf[32];
  { const bf16x8 a0 = *(const bf16x8*)(Z + tok * ZLD + ZLF), a1 = *(const bf16x8*)(Z + tok * ZLD + ZLF + 8), a2 = *(const bf16x8*)(Z + tok * ZLD + ZLF + 16), a3 = *(const bf16x8*)(Z + tok * ZLD + ZLF + 24);
    const bf16x8 k0 = *(const bf16x8*)(Z + tok * ZLD + ZGK + h * 32), k1 = *(const bf16x8*)(Z + tok * ZLD + ZGK + h * 32 + 8), k2 = *(const bf16x8*)(Z + tok * ZLD + ZGK + h * 32 + 16), k3 = *(const bf16x8*)(Z + tok * ZLD + ZGK + h * 32 + 24);
#pragma unroll
    for (int j = 0; j < 8; ++j) { lr[j] = bf2f((u16)a0[j]); lr[8 + j] = bf2f((u16)a1[j]); lr[16 + j] = bf2f((u16)a2[j]); lr[24 + j] = bf2f((u16)a3[j]);
      kf[j] = bf2f((u16)k0[j]); kf[8 + j] = bf2f((u16)k1[j]); kf[16 + j] = bf2f((u16)k2[j]); kf[24 + j] = bf2f((u16)k3[j]); } }
  float* GC = (float*)(p.ws + OFF_GC); float* DK = (float*)(p.ws + OFF_DK);
#pragma unroll
  for (int dir = 0; dir < 2; ++dir) {
    float cum[32];
#pragma unroll
    for (int d = 0; d < 32; ++d) {
      const float* up = UPT + (dir * 128 + h * 32 + d) * 16;
      const f32x4 u0 = *(const f32x4*)up, u1 = *(const f32x4*)(up + 4), u2 = *(const f32x4*)(up + 8), u3 = *(const f32x4*)(up + 12);
      float zz = BI[dir * 128 + h * 32 + d];
#pragma unroll
      for (int r = 0; r < 4; ++r) { zz = fmaf(lr[dir * 16 + r], u0[r], zz); zz = fmaf(lr[dir * 16 + 4 + r], u1[r], zz); zz = fmaf(lr[dir * 16 + 8 + r], u2[r], zz); zz = fmaf(lr[dir * 16 + 12 + r], u3[r], zz); }
      float g = logsig(zz) * (1.f / 16.f);
#pragma unroll
      for (int o = 1; o < 64; o <<= 1) { const float nb2 = dir ? __shfl_down(g, o) : __shfl_up(g, o); const bool ok = dir ? (lane + o < 64) : (lane >= o); g += ok ? nb2 : 0.f; }
      cum[d] = g;
    }
    float* gp = GC + tok * 256 + dir * 128 + h * 32;
#pragma unroll
    for (int d4 = 0; d4 < 8; ++d4) *(f32x4*)(gp + d4 * 4) = f32x4{cum[d4 * 4], cum[d4 * 4 + 1], cum[d4 * 4 + 2], cum[d4 * 4 + 3]};
#pragma unroll
    for (int d = 0; d < 32; ++d) {
      const float E = __shfl(cum[d], dir ? 0 : 63);
      if (lane == d) DK[((long)dir * NCHUNK + chunk) * 128 + h * 32 + d] = __expf(E);
      const float kp = kf[d] * __expf(E - cum[d]);
      *(u16*)(KT + (dir * 32 + d) * 144 + lane * 2) = f2bf(kp);
    }
  }
  bf16x8 vf[2][4];
#pragma unroll
  for (int et = 0; et < 2; ++et)
#pragma unroll
    for (int s4 = 0; s4 < 4; ++s4) vf[et][s4] = *(const bf16x8*)(VT + ((long)chunk * 256 + h * 64 + et * 32 + r32) * 64 + 16 * s4 + 8 * hi);
  asm volatile("s_waitcnt lgkmcnt(0)" ::: "memory");
#pragma unroll
  for (int dir = 0; dir < 2; ++dir) {
    f32x16 acc[2];
#pragma unroll
    for (int et = 0; et < 2; ++et)
#pragma unroll
      for (int r = 0; r < 16; ++r) acc[et][r] = 0.f;
#pragma unroll
    for (int s4 = 0; s4 < 4; ++s4) {
      const bf16x8 kb = *(const bf16x8*)(KT + (dir * 32 + r32) * 144 + (16 * s4 + 8 * hi) * 2);
      acc[0] = MFMA32(vf[0][s4], kb, acc[0]); acc[1] = MFMA32(vf[1][s4], kb, acc[1]);
    }
    float* L = (float*)(p.ws + OFF_LST) + (((long)dir * NCHUNK + chunk) * 4 + h) * 2048;
#pragma unroll
    for (int et = 0; et < 2; ++et)
#pragma unroll
      for (int r = 0; r < 16; ++r) L[(et * 32 + crow(r, hi)) * 32 + r32] = acc[et][r];
  }
}

DI void phase_gla_scan(const Params& p) {
  float* LST = (float*)(p.ws + OFF_LST); const float* DK = (const float*)(p.ws + OFF_DK);
  const long gt = (long)blockIdx.x * 512 + otid(), nthr = (long)gridDim.x * 512;
  for (long pid = gt; pid < 96L * 1024; pid += nthr) {
    const int sid = (int)(pid >> 10), within = (int)(pid & 1023), e = within >> 4, d = (within & 15) * 2;
    const int dir = sid / 48, r = sid % 48;
    int b, h, c0, n;
    if (r < 32) { b = r >> 2; h = r & 3; c0 = b * 128; n = 128; } else { b = (r - 32) >> 2; h = r & 3; c0 = 1024 + b * 64; n = 64; }
    float2 S = make_float2(0.f, 0.f);
    float2 La[8], Da[8], Lb[8], Db[8];
#define SC_ADDR(i) (dir ? (c0 + n - 1 - (i)) : (c0 + (i)))
#define SC_LOAD(L, D, i0_) do { _Pragma("unroll") for (int u = 0; u < 8; ++u) { const int ch = SC_ADDR(min((i0_) + u, n - 1));                 \
      L[u] = *(const float2*)(LST + (((long)dir * NCHUNK + ch) * 4 + h) * 2048 + e * 32 + d);                                                    \
      D[u] = *(const float2*)(DK + ((long)dir * NCHUNK + ch) * 128 + h * 32 + d); } } while (0)
#define SC_RUN(L, D, i0_) do { _Pragma("unroll") for (int u = 0; u < 8; ++u) { const int ch = SC_ADDR((i0_) + u);                               \
      *(float2*)(LST + (((long)dir * NCHUNK + ch) * 4 + h) * 2048 + e * 32 + d) = S;                                                             \
      S.x = fmaf(D[u].x, S.x, L[u].x); S.y = fmaf(D[u].y, S.y, L[u].y); } } while (0)
    SC_LOAD(La, Da, 0);
    for (int i0 = 0; i0 < n; i0 += 16) {
      SC_LOAD(Lb, Db, i0 + 8);
      SC_RUN(La, Da, i0);
      SC_LOAD(La, Da, i0 + 16);
      SC_RUN(Lb, Db, i0 + 8);
    }
#undef SC_ADDR
#undef SC_LOAD
#undef SC_RUN
  }
}

constexpr int SHM_GLA2 = 0;
DI void gla_out_wave(const Params& p, int l, int task) {
  const u16* Z = (const u16*)(p.ws + OFF_Z); const float* GC = (const float*)(p.ws + OFF_GC); u16* MIX = (u16*)(p.ws + OFF_MIX);
  const u16* VT = (const u16*)(p.ws + OFF_VT); const float* LST = (const float*)(p.ws + OFF_LST);
  const int chunk = task >> 2, h = task & 3; const long t0 = (long)chunk * 64;
  const int lane = otid() & 63, r32 = lane & 31, hi = lane >> 5;
  bf16x8 QEf[2][2], QEb[2][2], KEf[2][2], KEb[2][2];
#pragma unroll
  for (int t = 0; t < 2; ++t)
#pragma unroll
    for (int sdx = 0; sdx < 2; ++sdx) {
      const long tok = t0 + t * 32 + r32; const int d0 = 16 * sdx + 8 * hi;
      const bf16x8 qv = *(const bf16x8*)(Z + tok * ZLD + ZGQ + h * 32 + d0), kv = *(const bf16x8*)(Z + tok * ZLD + ZGK + h * 32 + d0);
      const f32x8 bv = *(const f32x8*)(GC + tok * 256 + h * 32 + d0), cv = *(const f32x8*)(GC + tok * 256 + 128 + h * 32 + d0);
      f32x8 a, b, c, d;
#pragma unroll
      for (int j = 0; j < 8; ++j) { const float q = bf2f((u16)qv[j]) * 0.17677669529663687f, k = bf2f((u16)kv[j]);
        const float eb = __expf(bv[j]), ec = __expf(cv[j]);
        a[j] = q * eb; b[j] = k * __builtin_amdgcn_rcpf(eb); c[j] = q * ec; d[j] = k * __builtin_amdgcn_rcpf(ec); }
      QEf[t][sdx] = cvt8(a); KEf[t][sdx] = cvt8(b); QEb[t][sdx] = cvt8(c); KEb[t][sdx] = cvt8(d);
    }
  bf16x8 VTf[2][4];
#pragma unroll
  for (int et = 0; et < 2; ++et)
#pragma unroll
    for (int s4 = 0; s4 < 4; ++s4) {
      const u16* vr = VT + ((long)chunk * 256 + h * 64 + et * 32 + r32) * 64 + 16 * s4 + 4 * hi;
      const s16x4 lo = *(const s16x4*)vr, up = *(const s16x4*)(vr + 8);
      VTf[et][s4] = (bf16x8){lo[0], lo[1], lo[2], lo[3], up[0], up[1], up[2], up[3]};
    }
  f32x16 o[2][2];
#pragma unroll
  for (int et = 0; et < 2; ++et)
#pragma unroll
    for (int it = 0; it < 2; ++it)
#pragma unroll
      for (int r = 0; r < 16; ++r) o[et][it][r] = 0.f;
#pragma unroll
  for (int it = 0; it < 2; ++it) {
    bf16x8 PB[2][2];
#pragma unroll
    for (int jt = 0; jt < 2; ++jt) {
      f32x16 af, ab;
#pragma unroll
      for (int r = 0; r < 16; ++r) { af[r] = 0.f; ab[r] = 0.f; }
      if (jt <= it) { af = MFMA32(KEf[jt][0], QEf[it][0], af); af = MFMA32(KEf[jt][1], QEf[it][1], af); }
      if (jt >= it) { ab = MFMA32(KEb[jt][0], QEb[it][0], ab); ab = MFMA32(KEb[jt][1], QEb[it][1], ab); }
      f32x16 a;
      if (jt < it) a = af; else if (jt > it) a = ab;
      else {
#pragma unroll
        for (int r = 0; r < 16; ++r) { const int jl = crow(r, hi); a[r] = (jl < r32) ? af[r] : ((jl > r32) ? ab[r] : af[r] + ab[r]); }
      }
      PB[jt][0] = pack8(a, 0); PB[jt][1] = pack8(a, 1);
    }
#pragma unroll
    for (int et = 0; et < 2; ++et)
#pragma unroll
      for (int s4 = 0; s4 < 4; ++s4) o[et][it] = MFMA32(VTf[et][s4], PB[s4 >> 1][s4 & 1], o[et][it]);
  }
#pragma unroll
  for (int dir = 0; dir < 2; ++dir)
#pragma unroll
    for (int et = 0; et < 2; ++et)
#pragma unroll
      for (int sdx = 0; sdx < 2; ++sdx) {
        const float* sp = LST + (((long)dir * NCHUNK + chunk) * 4 + h) * 2048 + (et * 32 + r32) * 32 + 16 * sdx + 8 * hi;
        const bf16x8 sf = cvt8(*(const f32x8*)sp);
#pragma unroll
        for (int it = 0; it < 2; ++it) o[et][it] = MFMA32(sf, dir ? QEb[it][sdx] : QEf[it][sdx], o[et][it]);
      }
#pragma unroll
  for (int it = 0; it < 2; ++it) {
    const long tok = t0 + it * 32 + r32;
    float ssq = 0.f;
#pragma unroll
    for (int et = 0; et < 2; ++et)
#pragma unroll
      for (int r = 0; r < 16; ++r) ssq = fmaf(o[et][it][r], o[et][it][r], ssq);
    ssq += __shfl_xor(ssq, 32);
    const float rs = rsqrtf(ssq * (1.f / 64.f) + EPS);
#pragma unroll
    for (int et = 0; et < 2; ++et)
#pragma unroll
      for (int q = 0; q < 4; ++q) {
        const int e0 = et * 32 + 8 * q + 4 * hi;
        const s16x4 gt = *(const s16x4*)(Z + tok * ZLD + ZGG + h * 64 + e0);
        const f32x4 gn = *(const f32x4*)(p.gla_norm_g + l * 64 + e0);
        float v[4];
#pragma unroll
        for (int j = 0; j < 4; ++j) v[j] = o[et][it][4 * q + j] * rs * gn[j] * silu(bf2f((u16)gt[j]));
        uint2 w; w.x = cvtpk(v[0], v[1]); w.y = cvtpk(v[2], v[3]);
        *(uint2*)(MIX + tok * 1024 + 768 + h * 64 + e0) = w;
      }
  }
}

template <int HALF> DI void pool_window(const u16* U, float* P, int c, int th, int s0, int SL) {
  float v[32 + 2 * HALF];
#pragma unroll
  for (int k = 0; k < 32 + 2 * HALF; ++k) v[k] = bf2f(U[(th * 32 + 8 - HALF + k) * 256 + c]);
  float run = 0.f;
#pragma unroll
  for (int k = 0; k < 2 * HALF; ++k) run += v[k];
#pragma unroll
  for (int ii = 0; ii < 32; ++ii) {
    const int i = th * 32 + ii, s = s0 + i, lo = max(s - HALF, 0), hi = min(s + HALF, SL);
    P[i * 256 + c] = run / (float)(hi - lo) - v[ii + HALF];
    if (ii < 31) run += v[ii + 2 * HALF] - v[ii];
  }
}
constexpr int SHM_POOL = 40960 + 65536;
DI void pool_chunk(const Params& p, int l, int chunk, char* lds) {
  const u16* Z = (const u16*)(p.ws + OFF_Z); u16* MIX = (u16*)(p.ws + OFF_MIX);
  u16* U = (u16*)lds; float* P = (float*)(lds + 40960);
  const int tid = otid();
  long tokbase; int s0, SL;
  if (chunk < 1024) { tokbase = (long)(chunk >> 7) * 8192; s0 = (chunk & 127) * 64; SL = 8192; }
  else { const int c = chunk - 1024; tokbase = NP + (long)(c >> 6) * 4096; s0 = (c & 63) * 64; SL = 4096; }
  __syncthreads();
  for (int i = tid; i < 80 * 32; i += 512) { const int r = i >> 5, c8 = (i & 31) * 8, s = s0 - 8 + r;
    bf16x8 v = {0, 0, 0, 0, 0, 0, 0, 0};
    if (s >= 0 && s < SL) v = *(const bf16x8*)(Z + (tokbase + s) * ZLD + ZUP + c8);
    *(bf16x8*)(U + r * 256 + c8) = v; }
  __syncthreads();
  { const int c = tid & 255, th = tid >> 8, gi = c >> 6;
    if (gi == 0) pool_window<1>(U, P, c, th, s0, SL); else if (gi == 1) pool_window<2>(U, P, c, th, s0, SL);
    else if (gi == 2) pool_window<4>(U, P, c, th, s0, SL); else pool_window<8>(U, P, c, th, s0, SL);
  }
  __syncthreads();
  { const int n = tid & 255, gi = n >> 6, d = n & 63, th = tid >> 8;
    const float* W = p.w_pool + (long)l * 4 * 64 * 64 + gi * 4096 + d;
    float acc[32];
#pragma unroll
    for (int ii = 0; ii < 32; ++ii) acc[ii] = 0.f;
    float wreg[64];
#pragma unroll
    for (int c = 0; c < 64; ++c) wreg[c] = W[c * 64];
#pragma unroll
    for (int c4 = 0; c4 < 16; ++c4) {
      const float w0 = wreg[c4 * 4 + 0], w1 = wreg[c4 * 4 + 1], w2 = wreg[c4 * 4 + 2], w3 = wreg[c4 * 4 + 3];
#pragma unroll
      for (int ii = 0; ii < 32; ++ii) { const f32x4 pv = *(const f32x4*)(P + (th * 32 + ii) * 256 + gi * 64 + c4 * 4);
        acc[ii] = fmaf(pv[0], w0, fmaf(pv[1], w1, fmaf(pv[2], w2, fmaf(pv[3], w3, acc[ii])))); }
    }
    const float sc = p.pool_scale[l * 256 + n];
#pragma unroll
    for (int ii = 0; ii < 32; ++ii) { const long t = (long)chunk * 64 + th * 32 + ii;
      const float g = bf2f(Z[t * ZLD + ZGP + n]);
      MIX[t * 1024 + 512 + n] = f2bf(acc[ii] * sc * silu(g)); }
  }
}

constexpr int KVBLK = 64;
constexpr int SHM_K = 64 * 384, SHM_V = 64 * 256;
constexpr int SHM_ATTN = 2 * SHM_V + 2 * SHM_K + 8 * 64 * 4;
constexpr float THR = 8.f;
#define KSWZ(row, colB) ((row) * 384 + ((colB) ^ ((((row) >> 1) & 7) << 4)))
DI void partialSM(f32x16& p0, f32x16& p1, float& m_reg, float& mn, float& alpha) {
  constexpr float C = MLA_SCALE * 1.4426950408889634f;
  float pmax = p0[0];
#pragma unroll
  for (int r = 1; r < 16; ++r) pmax = fmaxf(pmax, p0[r]);
#pragma unroll
  for (int r = 0; r < 16; ++r) pmax = fmaxf(pmax, p1[r]);
  { auto rr = __builtin_amdgcn_permlane32_swap(__float_as_uint(pmax), __float_as_uint(pmax), false, false);
    pmax = fmaxf(__uint_as_float(rr[0]), __uint_as_float(rr[1])); }
  if (__builtin_expect(__all(pmax - m_reg <= THR / MLA_SCALE), 1)) { mn = m_reg; alpha = 1.f; }
  else { mn = fmaxf(m_reg, pmax); alpha = __builtin_amdgcn_exp2f((m_reg - mn) * C); m_reg = mn; }
  const float mnC = -mn * C;
#pragma unroll
  for (int r = 0; r < 16; ++r) p0[r] = fmaf(p0[r], C, mnC);
#pragma unroll
  for (int r = 0; r < 16; ++r) p1[r] = fmaf(p1[r], C, mnC);
#pragma unroll
  for (int r = 0; r < 16; ++r) p0[r] = __builtin_amdgcn_exp2f(p0[r]);
}
DI void finishSM(f32x16& p0, f32x16& p1, float alpha, float& l_reg, bf16x8& pa0, bf16x8& pa1, bf16x8& pa2, bf16x8& pa3) {
#pragma unroll
  for (int r = 0; r < 16; ++r) p1[r] = __builtin_amdgcn_exp2f(p1[r]);
  float ps = 0;
#pragma unroll
  for (int r = 0; r < 16; ++r) ps += p0[r];
#pragma unroll
  for (int r = 0; r < 16; ++r) ps += p1[r];
  { auto rr = __builtin_amdgcn_permlane32_swap(__float_as_uint(ps), __float_as_uint(ps), false, false);
    ps = __uint_as_float(rr[0]) + __uint_as_float(rr[1]); }
  l_reg = l_reg * alpha + ps;
#define PK4(P, BASE, OUT) do { unsigned a0 = cvtpkv(P[BASE + 0], P[BASE + 1]), a1 = cvtpkv(P[BASE + 2], P[BASE + 3]);   \
    unsigned b0 = cvtpkv(P[BASE + 4], P[BASE + 5]), b1 = cvtpkv(P[BASE + 6], P[BASE + 7]);                              \
    auto r0 = __builtin_amdgcn_permlane32_swap(a0, b0, false, false); auto r1 = __builtin_amdgcn_permlane32_swap(a1, b1, false, false); \
    u32x4 w = {r0[0], r1[0], r0[1], r1[1]}; OUT = __builtin_bit_cast(bf16x8, w); } while (0)
  PK4(p0, 0, pa0); PK4(p0, 8, pa1); PK4(p1, 0, pa2); PK4(p1, 8, pa3);
#undef PK4
}
DI void qkt(f32x16& p0, f32x16& p1, const char* Ks, const bf16x8* qr, int kb0) {
#pragma unroll
  for (int r = 0; r < 16; ++r) { p0[r] = 0.f; p1[r] = 0.f; }
  int kq = kb0; asm volatile("" : "+v"(kq));
#pragma unroll
  for (int d0 = 0; d0 < 12; ++d0) { const int kb = kq ^ ((d0 & 3) << 5);
    const char* pk = Ks + kb + (d0 >> 2) * 128;
    bf16x8 b0 = *(const bf16x8*)(pk);
    bf16x8 b1 = *(const bf16x8*)(pk + 32 * 384);
    p0 = __builtin_amdgcn_mfma_f32_32x32x16_bf16(b0, qr[d0], p0, 0, 0, 0);
    p1 = __builtin_amdgcn_mfma_f32_32x32x16_bf16(b1, qr[d0], p1, 0, 0, 0); }
}
DI int v_st(int k, int c) { const int kk = (k & ~0xC) | ((k & 4) << 1) | ((k & 8) >> 1); return ((kk >> 3) * 4 + (c >> 5)) * 512 + ((kk & 7) * 32 + (c & 31)) * 2; }
DI int v_rd_base(int lane) { return ((lane & 3) << 3) | (((lane >> 2) & 3) << 6) | (((lane >> 4) & 1) << 5) | (((lane >> 5) & 1) << 8); }
constexpr int v_rd_off(int d0, int ks, int half) { return d0 * 512 + ks * 4096 + half * 2048; }
template <int OFF> DI s16x4 tr_read(int vb) {
  s16x4 r; asm volatile("ds_read_b64_tr_b16 %0, %1 offset:%2" : "=&v"(r) : "v"(vb), "i"(OFF) : "memory"); return r;
}
template <int D0> DI void pv_one(f32x16& od, int vb, bf16x8 pa0, bf16x8 pa1, bf16x8 pa2, bf16x8 pa3) {
  const s16x4 l0 = tr_read<v_rd_off(D0, 0, 0)>(vb), h0 = tr_read<v_rd_off(D0, 0, 1)>(vb), l1 = tr_read<v_rd_off(D0, 1, 0)>(vb), h1 = tr_read<v_rd_off(D0, 1, 1)>(vb);
  const s16x4 l2 = tr_read<v_rd_off(D0, 2, 0)>(vb), h2 = tr_read<v_rd_off(D0, 2, 1)>(vb), l3 = tr_read<v_rd_off(D0, 3, 0)>(vb), h3 = tr_read<v_rd_off(D0, 3, 1)>(vb);
  asm volatile("s_waitcnt lgkmcnt(0)" ::: "memory"); SBAR();
#define PK(L, H) (bf16x8){L[0], L[1], L[2], L[3], H[0], H[1], H[2], H[3]}
  od = __builtin_amdgcn_mfma_f32_32x32x16_bf16(PK(l0, h0), pa0, od, 0, 0, 0);
  od = __builtin_amdgcn_mfma_f32_32x32x16_bf16(PK(l1, h1), pa1, od, 0, 0, 0);
  od = __builtin_amdgcn_mfma_f32_32x32x16_bf16(PK(l2, h2), pa2, od, 0, 0, 0);
  od = __builtin_amdgcn_mfma_f32_32x32x16_bf16(PK(l3, h3), pa3, od, 0, 0, 0);
#undef PK
}
DI void pv_d0(f32x16* o, int vb, bf16x8 pa0, bf16x8 pa1, bf16x8 pa2, bf16x8 pa3) {
  pv_one<0>(o[0], vb, pa0, pa1, pa2, pa3); pv_one<1>(o[1], vb, pa0, pa1, pa2, pa3); pv_one<2>(o[2], vb, pa0, pa1, pa2, pa3); pv_one<3>(o[3], vb, pa0, pa1, pa2, pa3);
}

DI void attn_body(const u16* __restrict__ Qb, const u16* __restrict__ Kh, const u16* __restrict__ Wuv, const u16* __restrict__ Gp, u16* __restrict__ Mx, int seq, char* lds) {
  const int tid = otid(), wid = tid >> 6, lane = tid & 63, r32 = lane & 31, hi = lane >> 5;
  char* V_lds = lds; char* K_lds = lds + 2 * SHM_V;
  float m_reg = -1e30f, l_reg = 0; f32x16 o[4]; bf16x8 qr[12];
#pragma unroll
  for (int d = 0; d < 4; ++d)
#pragma unroll
    for (int r = 0; r < 16; ++r) o[d][r] = 0.f;
  const u16* Qw = Qb + (long)(wid * 32 + r32) * 768 + hi * 8;
#pragma unroll
  for (int d0 = 0; d0 < 12; ++d0) qr[d0] = *(const bf16x8*)(Qw + d0 * 16);
  const int sr = tid >> 4, sc = (tid & 15) * 8, vst0 = v_st(sr, sc);
  const int rr = tid >> 3, rcB = 256 + (tid & 7) * 16;
  const int kst0 = KSWZ(sr, sc * 2), kst2 = KSWZ(rr, rcB);
  const int vb0 = (int)(uintptr_t)V_lds + v_rd_base(lane);
  const int kswz = (r32 >> 1) & 7;
  const int kb0 = r32 * 384 + (((0 + hi) ^ kswz) << 4);
  bf16x8 sA0, sA1, sA2, sB0, sB1, sB2;
#define SLOADE(k0) do { sA0 = *(const bf16x8*)(Kh + (long)((k0) + sr) * 192 + sc); sA1 = *(const bf16x8*)(Kh + (long)((k0) + 32 + sr) * 192 + sc); \
    sA2 = *(const bf16x8*)(Kh + (long)((k0) + rr) * 192 + 128 + (tid & 7) * 8); } while (0)
#define SLOADO(k0) do { sB0 = *(const bf16x8*)(Kh + (long)((k0) + sr) * 192 + sc); sB1 = *(const bf16x8*)(Kh + (long)((k0) + 32 + sr) * 192 + sc); \
    sB2 = *(const bf16x8*)(Kh + (long)((k0) + rr) * 192 + 128 + (tid & 7) * 8); } while (0)
#define SWRITE(b, x0, x1, x2) do { *(bf16x8*)(V_lds + (b) * SHM_V + vst0) = x0; *(bf16x8*)(V_lds + (b) * SHM_V + vst0 + 8192) = x1;   \
    *(bf16x8*)(K_lds + (b) * SHM_K + kst0) = x0; *(bf16x8*)(K_lds + (b) * SHM_K + kst0 + 32 * 384) = x1; *(bf16x8*)(K_lds + (b) * SHM_K + kst2) = x2; } while (0)
#define SWAIT() asm volatile("s_waitcnt vmcnt(3)" ::: "memory")
#define RESC(a) do { if (__any((a) < 1.f)) { _Pragma("unroll") for (int d = 0; d < 4; ++d) _Pragma("unroll") for (int r = 0; r < 16; ++r) o[d][r] *= (a); } } while (0)
  f32x16 pA0, pA1, pB0, pB1; float mnA, mnB, alA, alB; bf16x8 pa0, pa1, pa2, pa3; const int NT = seq / KVBLK;
  SLOADE(0); asm volatile("s_waitcnt vmcnt(0)" ::: "memory"); SWRITE(0, sA0, sA1, sA2); __syncthreads();
  qkt(pA0, pA1, K_lds, qr, kb0); partialSM(pA0, pA1, m_reg, mnA, alA);
  SLOADO(KVBLK); SLOADE(2 * KVBLK);
  SWAIT(); SWRITE(1, sB0, sB1, sB2); __syncthreads();
  for (int j = 1; j + 1 < NT; j += 2) {
    SBAR(); qkt(pB0, pB1, K_lds + SHM_K, qr, kb0);
    finishSM(pA0, pA1, alA, l_reg, pa0, pa1, pa2, pa3); SBAR();
    SLOADO((j + 2) * KVBLK); SBAR();
    pv_d0(o, vb0, pa0, pa1, pa2, pa3); partialSM(pB0, pB1, m_reg, mnB, alB);
    __syncthreads(); SWAIT(); SWRITE(0, sA0, sA1, sA2);
    RESC(alB); __syncthreads();
    SBAR(); qkt(pA0, pA1, K_lds, qr, kb0);
    finishSM(pB0, pB1, alB, l_reg, pa0, pa1, pa2, pa3); SBAR();
    SLOADE(min(j + 3, NT - 1) * KVBLK); SBAR();
    pv_d0(o, vb0 + SHM_V, pa0, pa1, pa2, pa3); partialSM(pA0, pA1, m_reg, mnA, alA);
    __syncthreads(); SWAIT(); SWRITE(1, sB0, sB1, sB2);
    RESC(alA); __syncthreads();
  }
  SBAR(); qkt(pB0, pB1, K_lds + SHM_K, qr, kb0);
  finishSM(pA0, pA1, alA, l_reg, pa0, pa1, pa2, pa3); SBAR();
  pv_d0(o, vb0, pa0, pa1, pa2, pa3); partialSM(pB0, pB1, m_reg, mnB, alB);
  __syncthreads(); RESC(alB);
  finishSM(pB0, pB1, alB, l_reg, pa0, pa1, pa2, pa3); SBAR();
  pv_d0(o, vb0 + SHM_V, pa0, pa1, pa2, pa3);
  {
    const bf16x8 wl0 = *(const bf16x8*)(Wuv + (tid >> 2) * 128 + ((tid & 3) * 4 + 0) * 8), wl1 = *(const bf16x8*)(Wuv + (tid >> 2) * 128 + ((tid & 3) * 4 + 1) * 8);
    const bf16x8 wl2 = *(const bf16x8*)(Wuv + (tid >> 2) * 128 + ((tid & 3) * 4 + 2) * 8), wl3 = *(const bf16x8*)(Wuv + (tid >> 2) * 128 + ((tid & 3) * 4 + 3) * 8);
    const float rl = __builtin_amdgcn_rcpf(l_reg);
#pragma unroll
    for (int d = 0; d < 4; ++d)
#pragma unroll
      for (int r = 0; r < 16; ++r) o[d][r] *= rl;
    __syncthreads();
    { char* wrow = lds + (tid >> 2) * 264 + (tid & 3) * 64;
#define W8(off, v) do { *(s16x4*)(wrow + (off)) = (s16x4){v[0], v[1], v[2], v[3]}; *(s16x4*)(wrow + (off) + 8) = (s16x4){v[4], v[5], v[6], v[7]}; } while (0)
      W8(0, wl0); W8(16, wl1); W8(32, wl2); W8(48, wl3);
#undef W8
    }
    __syncthreads();
    f32x16 u2[4];
#pragma unroll
    for (int et = 0; et < 4; ++et)
#pragma unroll
      for (int r = 0; r < 16; ++r) u2[et][r] = 0.f;
#pragma unroll
    for (int s8 = 0; s8 < 8; ++s8) {
      const bf16x8 bfr = pack8(o[s8 >> 1], s8 & 1);
#pragma unroll
      for (int et = 0; et < 4; ++et) {
        const char* wp = lds + (et * 32 + r32) * 264 + (16 * s8 + 4 * hi) * 2;
        const s16x4 lo = *(const s16x4*)wp, up = *(const s16x4*)(wp + 16);
        const bf16x8 af = (bf16x8){lo[0], lo[1], lo[2], lo[3], up[0], up[1], up[2], up[3]};
        u2[et] = MFMA32(af, bfr, u2[et]);
      }
    }
    const long trow = wid * 32 + r32;
#pragma unroll
    for (int et = 0; et < 4; ++et)
#pragma unroll
      for (int q = 0; q < 4; ++q) {
        const int e0 = et * 32 + 8 * q + 4 * hi;
        const uint2 g = *(const uint2*)(Gp + trow * ZLD + e0);
        const float v0 = u2[et][4 * q + 0] * silu(__uint_as_float(g.x << 16)), v1 = u2[et][4 * q + 1] * silu(__uint_as_float(g.x & 0xffff0000u));
        const float v2 = u2[et][4 * q + 2] * silu(__uint_as_float(g.y << 16)), v3 = u2[et][4 * q + 3] * silu(__uint_as_float(g.y & 0xffff0000u));
        uint2 w; w.x = cvtpk(v0, v1); w.y = cvtpk(v2, v3);
        *(uint2*)(Mx + trow * 1024 + e0) = w;
      }
  }
#undef SLOADE
#undef SLOADO
#undef SWRITE
#undef SWAIT
#undef RESC
}

DI void phase_final_norm(const Params& p) {
  const u16* XBf = (const u16*)(p.ws + OFF_Q); const float* RS2 = (const float*)(p.ws + OFF_RS2);
  const int tidk = otid(); const int lane = tidk & 63, wv = blockIdx.x * 8 + (tidk >> 6), nw = gridDim.x * 8;
  f32x4 g[4];
#pragma unroll
  for (int i = 0; i < 4; ++i) g[i] = *(const f32x4*)(p.final_norm_g + lane * 16 + i * 4);
  for (int t = wv; t < NTOK; t += nw) {
    const bf16x8 a = *(const bf16x8*)(XBf + (long)t * 1024 + lane * 16), b = *(const bf16x8*)(XBf + (long)t * 1024 + lane * 16 + 8);
    const float rs = rsqrtf(RS2[t] * (1.f / 1024.f) + EPS);
    float* row = p.out + (long)t * 1024 + lane * 16;
    *(f32x4*)(row + 0) = f32x4{bf2f((u16)a[0]) * rs * g[0][0], bf2f((u16)a[1]) * rs * g[0][1], bf2f((u16)a[2]) * rs * g[0][2], bf2f((u16)a[3]) * rs * g[0][3]};
    *(f32x4*)(row + 4) = f32x4{bf2f((u16)a[4]) * rs * g[1][0], bf2f((u16)a[5]) * rs * g[1][1], bf2f((u16)a[6]) * rs * g[1][2], bf2f((u16)a[7]) * rs * g[1][3]};
    *(f32x4*)(row + 8) = f32x4{bf2f((u16)b[0]) * rs * g[2][0], bf2f((u16)b[1]) * rs * g[2][1], bf2f((u16)b[2]) * rs * g[2][2], bf2f((u16)b[3]) * rs * g[2][3]};
    *(f32x4*)(row + 12) = f32x4{bf2f((u16)b[4]) * rs * g[3][0], bf2f((u16)b[5]) * rs * g[3][1], bf2f((u16)b[6]) * rs * g[3][2], bf2f((u16)b[7]) * rs * g[3][3]};
  }
}

constexpr int REP_P1 = 1, REP_P2 = 1, REP_ATTN = 1, REP_P3B = 1, REP_P4 = 1, REP_POOL = 1, REP_GW = 1, REP_GL = 1;
constexpr int cmax(int a, int b) { return a > b ? a : b; }
constexpr int SHM_TOTAL = cmax(cmax(SHM_GEMM, SHM_ATTN), cmax(cmax(SHM_GLA1, SHM_GLA2), SHM_POOL));

__global__ void __launch_bounds__(512, 1) hymba_megakernel(Params p) {
  __shared__ __attribute__((aligned(16))) char lds[SHM_TOTAL];
  cg::grid_group grid = cg::this_grid();
  const int nb = gridDim.x, bid = blockIdx.x;
  const int xcd = bid & 7, xloc = bid >> 3, xn = (nb - xcd + 7) >> 3;
  u16* Z = (u16*)(p.ws + OFF_Z); u16* Qg = (u16*)(p.ws + OFF_Q); u16* Kg = (u16*)(p.ws + OFF_K); u16* OL = (u16*)(p.ws + OFF_OL); u16* MIX = (u16*)(p.ws + OFF_MIX);
  if (blockIdx.x == 0 && threadIdx.x < 2) ((unsigned*)(p.ws + OFF_SC))[threadIdx.x * 64] = 0u;
  u16* XB = (u16*)(p.ws + OFF_Q);
  phase_weights(p, lds);
  {
    float* RS0 = (float*)(p.ws + OFF_RS0); float* RS1 = (float*)(p.ws + OFF_RS1);
    const int tk = otid(), lane = tk & 63;
    for (int tok = bid * 8 + (tk >> 6); tok < NTOK; tok += nb * 8) {
      const float* src = (tok < NP ? p.x_prompt + (long)tok * 1024 : p.x_sample + (long)(tok - NP) * 1024) + lane * 16;
      const f32x8 a = *(const f32x8*)src, b2 = *(const f32x8*)(src + 8);
      float ss = 0.f;
#pragma unroll
      for (int j = 0; j < 8; ++j) ss = fmaf(a[j], a[j], fmaf(b2[j], b2[j], ss));
      *(bf16x8*)(XB + (long)tok * 1024 + lane * 16) = cvt8(a); *(bf16x8*)(XB + (long)tok * 1024 + lane * 16 + 8) = cvt8(b2);
#pragma unroll
      for (int o = 1; o < 64; o <<= 1) ss += __shfl_xor(ss, o);
      if (lane == 0) { RS0[tok] = ss; RS1[tok] = 0.f; ((float*)(p.ws + OFF_RS2))[tok] = 0.f; }
    }
  }
  grid.sync();
#pragma unroll 1
  for (int l = 0; l < 2; ++l) {
    {
      pg8::Gemm g; g.A = XB; g.Bt = (const u16*)(p.ws + OFF_WIN + l * SZ_WIN); g.M = NTOK; g.N = ZLD; g.K = 1024;
      pg8::StaticOrder S; S.init(NTOK, ZLD, nb, bid);
      pg8::EpiZ E; E.Z = Z; E.VT = (u16*)(p.ws + OFF_VT); E.rowss = (const float*)(p.ws + (l == 0 ? OFF_RS0 : OFF_RS1));
      __syncthreads();
      pg8::gemm_phase<pg8::EpiZ, pg8::StaticOrder>((PG8_LAS unsigned char*)lds, g, S, E);
    }
    grid.sync();
    {
      Epi ep{}; ep.outb = Qg; ep.ldo = 768; ep.cs = (const float2*)(p.ws + OFF_CS);
      const u16* Wt = (const u16*)(p.ws + OFF_WQ + l * SZ_WQ);
      for (int rep = 0; rep < REP_P2; ++rep)
      for (int t = bid; t < 320 * 3; t += nb) { const int mb = t / 3, nt = t % 3; gemm_tile<EPI_Q, 4>(Z + ZQ, ZLD, Wt, 256, 256, (long)mb * 256, nt * 256, lds, ep); }
      __syncthreads(); glw_stage(p, l, lds); __syncthreads();
      for (int r2 = 0; r2 < REP_GL; ++r2) for (int task = bid * 8 + (otid() >> 6); task < 4 * NCHUNK; task += nb * 8) gla_local_wave(p, l, task, lds);
      phase_kbuild(p, l);
    }
    grid.sync();
    {
      unsigned* sc = (unsigned*)(p.ws + OFF_SC) + l * 64;
      phase_gla_scan(p);
      asm volatile("s_waitcnt vmcnt(0)" ::: "memory");
      __syncthreads();
      if (threadIdx.x == 0) { __builtin_amdgcn_fence(__ATOMIC_RELEASE, "agent"); asm volatile("s_waitcnt vmcnt(0)" ::: "memory");
        (void)__hip_atomic_fetch_add(sc, 1u, __ATOMIC_RELAXED, __HIP_MEMORY_SCOPE_AGENT); }
      for (int it = bid; it < 1280; it += nb) {
        long tokbase; int h, qb, seq;
        if (it < 1024) { tokbase = (long)(it >> 7) * 8192; h = (it >> 5) & 3; qb = it & 31; seq = 8192; }
        else { const int i2 = it - 1024; tokbase = NP + (long)(i2 >> 6) * 4096; h = (i2 >> 4) & 3; qb = i2 & 15; seq = 4096; }
        __syncthreads();
        attn_body(Qg + (tokbase + qb * 256) * 768 + h * 192, Kg + tokbase * 192, (const u16*)(p.ws + OFF_WUV + l * SZ_WUV) + h * 128 * 128,
                  Z + (tokbase + qb * 256) * ZLD + ZGM + h * 128, MIX + (tokbase + qb * 256) * 1024 + h * 128, seq, lds);
      }
      for (int t = bid; t < NCHUNK; t += nb) pool_chunk(p, l, t, lds);
      if (threadIdx.x == 0) {
        while (__hip_atomic_load(sc, __ATOMIC_RELAXED, __HIP_MEMORY_SCOPE_AGENT) < (unsigned)nb) __builtin_amdgcn_s_sleep(2);
        __builtin_amdgcn_fence(__ATOMIC_ACQUIRE, "agent"); asm volatile("s_waitcnt vmcnt(0)" ::: "memory");
      }
      __syncthreads();
      for (int task = bid * 8 + (otid() >> 6); task < 4 * NCHUNK; task += nb * 8) gla_out_wave(p, l, task);
    }
    grid.sync();
    {
      pg8::Gemm g; g.A = MIX; g.Bt = (const u16*)(p.ws + OFF_WOUT + l * SZ_WOUT); g.M = NTOK; g.N = 1024; g.K = 1024;
      pg8::StaticOrder S; S.init(NTOK, 1024, nb, bid);
      pg8::EpiRes E; E.out = (l == 0) ? p.out : nullptr; E.rp = (l == 0) ? p.x_prompt : p.out; E.rsm = (l == 0) ? p.x_sample - (long)NP * 1024 : p.out;
      E.xb = XB; E.rowss = (float*)(p.ws + (l == 0 ? OFF_RS1 : OFF_RS2));
      __syncthreads();
      pg8::gemm_phase<pg8::EpiRes, pg8::StaticOrder>((PG8_LAS unsigned char*)lds, g, S, E);
    }
    grid.sync();
  }
  phase_final_norm(p);
}

extern "C" void kernel_launch(void* const* d_in, const int* in_sizes, int n_in, void* d_out, int out_size, void* d_ws, size_t ws_size, hipStream_t stream) {
  static int grid_blocks = 0;
  if (!grid_blocks) {
    int dev = 0, cus = 0, per_cu = 0;
    hipGetDevice(&dev);
    hipDeviceGetAttribute(&cus, hipDeviceAttributeMultiprocessorCount, dev);
    hipOccupancyMaxActiveBlocksPerMultiprocessor(&per_cu, hymba_megakernel, 512, 0);
    if (per_cu < 1) per_cu = 1;
    if (per_cu > 1) per_cu = 1;
    grid_blocks = cus * per_cu;
  }
  if (n_in != 17 || ws_size < WS_END) { fprintf(stderr, "kernel_launch: bad args n_in %d ws %zu need %zu\n", n_in, ws_size, WS_END); return; }
  Params p{};
  p.x_prompt = (const float*)d_in[0]; p.x_sample = (const float*)d_in[1]; p.norm_g = (const float*)d_in[2]; p.w_in = (const float*)d_in[3];
  p.q_norm_g = (const float*)d_in[4]; p.w_uq = (const float*)d_in[5]; p.kv_norm_g = (const float*)d_in[6]; p.w_ukv = (const float*)d_in[7];
  p.w_pool = (const float*)d_in[8]; p.pool_scale = (const float*)d_in[9]; p.gk_up_fwd = (const float*)d_in[10]; p.gk_bias_fwd = (const float*)d_in[11];
  p.gk_up_bwd = (const float*)d_in[12]; p.gk_bias_bwd = (const float*)d_in[13]; p.gla_norm_g = (const float*)d_in[14]; p.w_out = (const float*)d_in[15];
  p.final_norm_g = (const float*)d_in[16]; p.out = (float*)d_out; p.ws = (char*)d_ws;
  void* args[] = {&p};
  hipError_t e = hipLaunchCooperativeKernel((void*)hymba_megakernel, dim3(grid_blocks), dim3(512), args, 0, stream);
  if (e != hipSuccess) fprintf(stderr, "cooperative launch failed: %s (grid %d)\n", hipGetErrorString(e), grid_blocks);
}
```
